# Optimizing an MI355X kernel written in HIP

```python
import jax, jax.numpy as jnp
from jax import lax
import numpy as np

D_MODEL = 1024
BATCH = 4
SEQ = 8192
DEPTH = 2

GRID_W = 64
CTX_LEN = 256
HEAD_DIM = 64
MIX_WIDTH = D_MODEL
A_HEADS = 6
A_KV = 2
A_WINDOW = 128
A_BLOCK = 128
B_HEADS = 4
B_KV = 2
B_BLOCK = 128
C_HEADS = 6
NA_KH = 8
NA_KW = 16
D_FF = 2816
ROPE_THETA = 10000.0
EPS = 1e-6
N_MOD = 9
NEG = -1e30
KV_WIDTHS = (A_KV, A_KV, B_KV, B_KV, C_HEADS, C_HEADS)
W_IN_COLS = MIX_WIDTH + sum(KV_WIDTHS) * HEAD_DIM

kernel_name = "hybrid_dit_parallel_heads_ctx_prefix"


def _rms_norm(x, g):
    xf = x.astype(jnp.float32)
    y = xf * lax.rsqrt(jnp.mean(xf * xf, axis=-1, keepdims=True) + EPS)
    return (y * g.astype(jnp.float32)).astype(x.dtype)


def _modulate(u, shift, scale):
    return u * (1.0 + scale) + shift


def _swiglu(u, w_gate, w_up, w_down):
    return (jax.nn.silu(u @ w_gate) * (u @ w_up)) @ w_down


def _axial_rope(S):
    t = jnp.arange(S)
    row = (t // GRID_W).astype(jnp.float32)
    col = (t % GRID_W).astype(jnp.float32)
    n_freq = HEAD_DIM // 4
    inv = ROPE_THETA ** (-jnp.arange(n_freq, dtype=jnp.float32) / n_freq)
    ang = jnp.concatenate([row[:, None] * inv, col[:, None] * inv], axis=-1)
    return jnp.cos(ang), jnp.sin(ang)


def _rope(x, cos, sin):
    half = HEAD_DIM // 2
    x1, x2 = x[..., :half], x[..., half:]
    cs, sn = cos[None, :, None, :], sin[None, :, None, :]
    return jnp.concatenate([x1 * cs - x2 * sn, x2 * cs + x1 * sn], axis=-1).astype(x.dtype)


def _multi_softmax(logits):
    sizes = [int(l.shape[-1]) for l in logits]
    p = jax.nn.softmax(jnp.concatenate(logits, axis=-1), axis=-1)
    return jnp.split(p, [int(s) for s in np.cumsum(sizes)[:-1]], axis=-1)


def _heads(t, n):
    return t.reshape(*t.shape[:-1], n, HEAD_DIM)


def _split_q(p):
    a = A_HEADS * HEAD_DIM
    b = B_HEADS * HEAD_DIM
    return (_heads(p[..., :a], A_HEADS), _heads(p[..., a:a + b], B_HEADS),
            _heads(p[..., a + b:MIX_WIDTH], C_HEADS))


def _split_kv(p):
    offs = [0]
    for w in KV_WIDTHS:
        offs.append(offs[-1] + w * HEAD_DIM)
    return [_heads(p[..., offs[i]:offs[i + 1]], KV_WIDTHS[i]) for i in range(len(KV_WIDTHS))]


def _ctx_attn(qc, kc, vc, sink=None):
    Bn, L, H, d = qc.shape
    KV = kc.shape[2]
    G = H // KV
    qg = qc.reshape(Bn, L, KV, G, d)
    s = jnp.einsum('bqkgd,blkd->bkgql', qg, kc).astype(jnp.float32) * (d ** -0.5)
    if sink is None:
        p = jax.nn.softmax(s, axis=-1)
    else:
        sink_col = jnp.broadcast_to(sink.astype(jnp.float32).reshape(1, KV, G, 1, 1), (Bn, KV, G, L, 1))
        p, _ = _multi_softmax([s, sink_col])
    out = jnp.einsum('bkgql,blkd->bqkgd', p.astype(vc.dtype), vc)
    return out.reshape(Bn, L, H * d)


def _window_attn(q, k, v, kc, vc, sink):
    Bn, S, H, d = q.shape
    KV = k.shape[2]
    G = H // KV
    nb = S // A_BLOCK
    band = 3 * A_BLOCK
    scale = d ** -0.5
    pad = ((0, 0), (A_BLOCK, A_BLOCK), (0, 0), (0, 0))
    kp, vp = jnp.pad(k, pad), jnp.pad(v, pad)
    qb = jnp.moveaxis(q.reshape(Bn, nb, A_BLOCK, KV, G, d), 1, 0)
    rel = jnp.arange(band)[None, :] - A_BLOCK - jnp.arange(A_BLOCK)[:, None]
    sink_col = jnp.broadcast_to(sink.astype(jnp.float32).reshape(1, KV, G, 1, 1), (Bn, KV, G, A_BLOCK, 1))

    def block(args):
        n, q_n = args
        start = n * A_BLOCK
        k_n = lax.dynamic_slice_in_dim(kp, start, band, axis=1)
        v_n = lax.dynamic_slice_in_dim(vp, start, band, axis=1)
        kpos = start - A_BLOCK + jnp.arange(band)
        mask = (jnp.abs(rel) <= A_WINDOW) & ((kpos >= 0) & (kpos < S))[None, :]
        s_w = jnp.einsum('bqkgd,bskd->bkgqs', q_n, k_n).astype(jnp.float32) * scale
        s_w = jnp.where(mask, s_w, NEG)
        s_c = jnp.einsum('bqkgd,blkd->bkgql', q_n, kc).astype(jnp.float32) * scale
        p_w, p_c, _ = _multi_softmax([s_w, s_c, sink_col])
        return (jnp.einsum('bkgqs,bskd->bqkgd', p_w.astype(v.dtype), v_n)
                + jnp.einsum('bkgql,blkd->bqkgd', p_c.astype(vc.dtype), vc))

    out = lax.map(block, (jnp.arange(nb), qb))
    return jnp.moveaxis(out, 0, 1).reshape(Bn, S, H * d)


def _global_attn(q, k, v, kc, vc):
    Bn, S, H, d = q.shape
    KV = k.shape[2]
    G = H // KV
    nb = S // B_BLOCK
    scale = d ** -0.5
    qb = jnp.moveaxis(q.reshape(Bn, nb, B_BLOCK, KV, G, d), 1, 0)

    def block(q_n):
        s_l = jnp.einsum('bqkgd,bskd->bkgqs', q_n, k).astype(jnp.float32) * scale
        s_c = jnp.einsum('bqkgd,blkd->bkgql', q_n, kc).astype(jnp.float32) * scale
        p_l, p_c = _multi_softmax([s_l, s_c])
        return (jnp.einsum('bkgqs,bskd->bqkgd', p_l.astype(v.dtype), v)
                + jnp.einsum('bkgql,blkd->bqkgd', p_c.astype(vc.dtype), vc))

    out = lax.map(block, qb)
    return jnp.moveaxis(out, 0, 1).reshape(Bn, S, H * d)


def _neighbourhood_attn(q, k, v, kc, vc, rpb):
    Bn, S, H, d = q.shape
    rows = S // GRID_W
    kh = min(NA_KH, rows)
    kw = NA_KW
    n_keys = kh * kw
    scale = d ** -0.5
    qg = jnp.moveaxis(q.reshape(Bn, rows, GRID_W, H, d), 1, 0)
    kg = k.reshape(Bn, rows, GRID_W, H, d)
    vg = v.reshape(Bn, rows, GRID_W, H, d)
    cols = np.arange(GRID_W)
    col_idx = np.clip(cols - kw // 2, 0, GRID_W - kw)[:, None] + np.arange(kw)[None, :]
    dc = col_idx - cols[:, None] + NA_KW - 1
    rpb_col = rpb[:, :, dc]

    def gather(t, rs):
        t_rows = lax.dynamic_slice_in_dim(t, rs, kh, axis=1)
        t_nb = t_rows[:, :, col_idx]
        return jnp.transpose(t_nb, (0, 2, 1, 3, 4, 5)).reshape(Bn, GRID_W, n_keys, H, d)

    def block(args):
        r, q_r = args
        rs = jnp.clip(r - kh // 2, 0, rows - kh)
        dr = rs + jnp.arange(kh) - r + NA_KH - 1
        bias = jnp.transpose(jnp.take(rpb_col, dr, axis=1), (0, 2, 1, 3)).reshape(H, GRID_W, n_keys)
        k_nb, v_nb = gather(kg, rs), gather(vg, rs)
        s_n = jnp.einsum('bwhd,bwnhd->bhwn', q_r, k_nb).astype(jnp.float32) * scale + bias.astype(jnp.float32)
        s_c = jnp.einsum('bwhd,blhd->bhwl', q_r, kc).astype(jnp.float32) * scale
        p_n, p_c = _multi_softmax([s_n, s_c])
        return (jnp.einsum('bhwn,bwnhd->bwhd', p_n.astype(v.dtype), v_nb)
                + jnp.einsum('bhwl,blhd->bwhd', p_c.astype(vc.dtype), vc))

    out = lax.map(block, (jnp.arange(rows), qg))
    return jnp.moveaxis(out, 0, 1).reshape(Bn, S, H * d)


def setup_inputs(seed: int = 0) -> dict:
    key = jax.random.key(seed)
    ks = jax.random.split(key, 24)
    f32 = jnp.float32
    D, F = D_MODEL, D_FF

    def nrm(k, shape, s):
        return jax.random.normal(k, shape, f32) * s

    def gain(k, shape):
        return 1.0 + 0.02 * jax.random.normal(k, shape, f32)

    return {
        "x": nrm(ks[0], (BATCH, SEQ, D), 1.0),
        "c": nrm(ks[1], (BATCH, D), 1.0),
        "ctx": nrm(ks[2], (BATCH, CTX_LEN, D), 1.0),
        "c_ctx": nrm(ks[3], (D,), 1.0),
        "w_ada": nrm(ks[4], (DEPTH, D, N_MOD * D), 0.5 * D ** -0.5),
        "b_ada": nrm(ks[5], (DEPTH, N_MOD * D), 0.02),
        "norm_ffn1": gain(ks[6], (DEPTH, D)),
        "w_ffn1_gate": nrm(ks[7], (DEPTH, D, F), D ** -0.5),
        "w_ffn1_up": nrm(ks[8], (DEPTH, D, F), D ** -0.5),
        "w_ffn1_down": nrm(ks[9], (DEPTH, F, D), F ** -0.5),
        "norm_mix": gain(ks[10], (DEPTH, D)),
        "w_in": nrm(ks[11], (DEPTH, D, W_IN_COLS), D ** -0.5),
        "q_norm_glob": gain(ks[12], (DEPTH, HEAD_DIM)),
        "k_norm_glob": gain(ks[13], (DEPTH, HEAD_DIM)),
        "sink_win": nrm(ks[14], (DEPTH, A_HEADS), 0.5),
        "rpb_nbr": nrm(ks[15], (DEPTH, C_HEADS, 2 * NA_KH - 1, 2 * NA_KW - 1), 0.1),
        "w_out": nrm(ks[16], (DEPTH, MIX_WIDTH, D), MIX_WIDTH ** -0.5),
        "norm_ffn2": gain(ks[17], (DEPTH, D)),
        "w_ffn2_gate": nrm(ks[18], (DEPTH, D, F), D ** -0.5),
        "w_ffn2_up": nrm(ks[19], (DEPTH, D, F), D ** -0.5),
        "w_ffn2_down": nrm(ks[20], (DEPTH, F, D), F ** -0.5),
        "norm_final": gain(ks[21], (D,)),
    }


def reference(x, c, ctx, c_ctx, w_ada, b_ada, norm_ffn1, w_ffn1_gate, w_ffn1_up, w_ffn1_down,
              norm_mix, w_in, q_norm_glob, k_norm_glob, sink_win, rpb_nbr, w_out,
              norm_ffn2, w_ffn2_gate, w_ffn2_up, w_ffn2_down, norm_final):
    S = x.shape[1]
    cos, sin = _axial_rope(S)
    h, hc = x, ctx
    for l in range(DEPTH):
        last = l == DEPTH - 1
        mod_x = (jax.nn.silu(c) @ w_ada[l] + b_ada[l])[:, None, :]
        mod_c = jax.nn.silu(c_ctx) @ w_ada[l] + b_ada[l]
        sh1, sc1, g1, shm, scm, gm, sh2, sc2, g2 = jnp.split(mod_x, N_MOD, axis=-1)
        csh1, csc1, cg1, cshm, cscm, cgm, csh2, csc2, cg2 = jnp.split(mod_c, N_MOD, axis=-1)

        h = h + 0.5 * g1 * _swiglu(_modulate(_rms_norm(h, norm_ffn1[l]), sh1, sc1),
                                   w_ffn1_gate[l], w_ffn1_up[l], w_ffn1_down[l])
        hc = hc + 0.5 * cg1 * _swiglu(_modulate(_rms_norm(hc, norm_ffn1[l]), csh1, csc1),
                                      w_ffn1_gate[l], w_ffn1_up[l], w_ffn1_down[l])

        u = _modulate(_rms_norm(h, norm_mix[l]), shm, scm)
        uc = _modulate(_rms_norm(hc, norm_mix[l]), cshm, cscm)
        p = u @ w_in[l]
        q_w, q_g, q_n = _split_q(p[..., :MIX_WIDTH])
        k_w, v_w, k_g, v_g, k_n, v_n = _split_kv(p[..., MIX_WIDTH:])
        if last:
            kv_c = uc @ w_in[l][:, MIX_WIDTH:]
        else:
            pc = uc @ w_in[l]
            cq_w, cq_g, cq_n = _split_q(pc[..., :MIX_WIDTH])
            kv_c = pc[..., MIX_WIDTH:]
        ck_w, cv_w, ck_g, cv_g, ck_n, cv_n = _split_kv(kv_c)

        q_g = _rms_norm(q_g, q_norm_glob[l])
        k_g = _rms_norm(k_g, k_norm_glob[l])
        ck_g = _rms_norm(ck_g, k_norm_glob[l])
        q_w, k_w = _rope(q_w, cos, sin), _rope(k_w, cos, sin)
        q_g, k_g = _rope(q_g, cos, sin), _rope(k_g, cos, sin)

        y_w = _window_attn(q_w, k_w, v_w, ck_w, cv_w, sink_win[l])
        y_g = _global_attn(q_g, k_g, v_g, ck_g, cv_g)
        y_n = _neighbourhood_attn(q_n, k_n, v_n, ck_n, cv_n, rpb_nbr[l])
        h = h + gm * (jnp.concatenate([y_w, y_g, y_n], axis=-1) @ w_out[l])

        if not last:
            cq_g = _rms_norm(cq_g, q_norm_glob[l])
            yc = jnp.concatenate([_ctx_attn(cq_w, ck_w, cv_w, sink_win[l]),
                                  _ctx_attn(cq_g, ck_g, cv_g),
                                  _ctx_attn(cq_n, ck_n, cv_n)], axis=-1)
            hc = hc + cgm * (yc @ w_out[l])

        h = h + 0.5 * g2 * _swiglu(_modulate(_rms_norm(h, norm_ffn2[l]), sh2, sc2),
                                   w_ffn2_gate[l], w_ffn2_up[l], w_ffn2_down[l])
        if not last:
            hc = hc + 0.5 * cg2 * _swiglu(_modulate(_rms_norm(hc, norm_ffn2[l]), csh2, csc2),
                                          w_ffn2_gate[l], w_ffn2_up[l], w_ffn2_down[l])
    return _rms_norm(h, norm_final)
```

```cpp
#include <hip/hip_runtime.h>
#include <hip/hip_cooperative_groups.h>
#include <cstdio>
#include <cstdint>
namespace cg = cooperative_groups;
namespace pg8 {
#define PG8_LAS __attribute__((address_space(3)))
typedef unsigned short bf16_t;
typedef short bf16x8 __attribute__((ext_vector_type(8)));
typedef float f32x4 __attribute__((ext_vector_type(4)));
typedef unsigned u32x4 __attribute__((ext_vector_type(4)));
constexpr int BM = 256, BK = 64, HALF = 128, HTB = HALF * BK * 2  , STAGE_BYTES = 8 * HTB, NXCD = 8, WGM = 8;

__host__ __device__ __forceinline__ int lds_byte(int r, int c) { const int st = (r >> 4) * 2 + (c >> 5), rr = r & 15, cc = c & 31, ob = rr * 64 + cc * 2; return st * 1024 + (ob ^ (((ob >> 9) & 1) << 5)); }
__host__ __device__ __forceinline__ void stage_rc(int b, int& R, int& C) { const int st = b / 1024, sb = b % 1024, swz = sb ^ (((sb >> 9) & 1) << 5); R = (st >> 1) * 16 + swz / 64; C = (st & 1) * 32 + (swz % 64) / 2; }
__host__ __device__ __forceinline__ int perm32(int rho) { const int n = rho >> 4, i = rho & 15; return 8 * (i >> 2) + 4 * n + (i & 3); }

struct Unit { int pm, pn, k0t, nt, ks; };
struct Gemm { const bf16_t* A; const bf16_t* Bt; int M, N, K; };

struct StaticOrder {
    int nM, nN, nwg, G, c, ntk, pmoff;
    __host__ __device__ __forceinline__ void init(int M, int N, int G_, int c_, int K_, int pmoff_ = 0) { nM = M / BM; nN = N / BM; nwg = nM * nN; G = G_; c = c_; ntk = K_ / BK; pmoff = pmoff_; }
    __host__ __device__ __forceinline__ bool next(int i, Unit& u) const {
        const long L = (long)i * G + c; if (L >= nwg) return false;
        int wgid = (int)L; { const int q = nwg / NXCD, r = nwg % NXCD, xcd = wgid % NXCD, off = wgid / NXCD; wgid = (xcd < r ? xcd * (q + 1) : r * (q + 1) + (xcd - r) * q) + off; }
        const int nig = WGM * nN, gid = wgid / nig, fm = gid * WGM, gsz = (nM - fm) < WGM ? (nM - fm) : WGM;
        u.pm = pmoff + fm + ((wgid % nig) % gsz); u.pn = (wgid % nig) / gsz; u.k0t = 0; u.nt = ntk; u.ks = -1; return true;
    }
    __device__ __forceinline__ void a_ready(const Unit&) const {}
    __device__ __forceinline__ void done(const Unit&) const {}
};

#ifndef REV_ORDER
#define REV_ORDER 1
#endif
struct CtxSplitOrder {
    StaticOrder lat; int G, c, nsub, pmmask;
    __host__ __device__ __forceinline__ void init(int G_, int c_, int K_, int nsub_, int latM, int pmoff_, int pmmask_) { lat.init(latM, 1024, G_, c_, K_, pmoff_); G = G_; c = c_; nsub = nsub_; pmmask = pmmask_; }
    __host__ __device__ __forceinline__ bool next(int i, Unit& u) const {
        const int L = i * G + c; const bool islat = L < lat.nwg;
        const int Ll = islat ? L : 0;
        int wgid = Ll; { const int q = lat.nwg / NXCD, r = lat.nwg % NXCD, xcd = wgid % NXCD, off = wgid / NXCD; wgid = (xcd < r ? xcd * (q + 1) : r * (q + 1) + (xcd - r) * q) + off; }
        wgid = REV_ORDER ? (lat.nwg - 1 - wgid) : wgid;
        const int nig = WGM * lat.nN, gid = wgid / nig, fm = gid * WGM, gsz = (lat.nM - fm) < WGM ? (lat.nM - fm) : WGM;
        const int lpm = lat.pmoff + fm + ((wgid % nig) % gsz), lpn = (wgid % nig) / gsz;
        const int j = islat ? 0 : L - lat.nwg, ks = j & 3;
        u.pm = islat ? (lpm & pmmask) : 128 + (j >> 4); u.pn = islat ? lpn : (j >> 2) & 3; u.ks = islat ? -1 : ks;
        u.k0t = islat ? 0 : ks * 12 - (ks == 3 ? 2 : 0); u.nt = islat ? lat.ntk : 12 - 2 * (ks >> 1);
        return islat || (L - lat.nwg) < nsub;
    }
    __device__ __forceinline__ void a_ready(const Unit&) const {}
    __device__ __forceinline__ void done(const Unit&) const {}
};

__device__ __forceinline__ unsigned cvt_pk_bf16(float lo, float hi) { unsigned r; asm volatile("v_cvt_pk_bf16_f32 %0, %1, %2" : "=v"(r) : "v"(lo), "v"(hi)); return r; }
typedef float f32x2 __attribute__((ext_vector_type(2)));
constexpr int D_MODEL = 1024, N_LAT = 32768, MODROW = 9216;
__device__ __forceinline__ unsigned cvt_pk_nv(float lo, float hi) { unsigned r; asm("v_cvt_pk_bf16_f32 %0, %1, %2" : "=v"(r) : "v"(lo), "v"(hi)); return r; }
__device__ __forceinline__ float silu_mul(float g, float u) { return g * __builtin_amdgcn_rcpf(1.0f + __builtin_amdgcn_exp2f(-1.4426950408889634f * g)) * u; }

__device__ __forceinline__ f32x4 silu_mul4(f32x4 g, f32x4 u) {
    f32x4 t = g * (-1.4426950408889634f), gu = g * u;
#pragma unroll
    for (int i = 0; i < 4; ++i) t[i] = __builtin_amdgcn_exp2f(t[i]);
    t = t + 1.0f;
#pragma unroll
    for (int i = 0; i < 4; ++i) t[i] = __builtin_amdgcn_rcpf(t[i]);
    return gu * t;
}
struct EpiSwiGLU {
    static constexpr bool PERM = true, AFTER_DRAIN = false; static constexpr int A_AUX = 0;
    bf16_t* O; int ldc;
    __device__ __forceinline__ void operator()(const f32x4 (&acc)[2][2][4][2], const Unit& u, int wr, int wc, int fr, int fq) const {
        const int row0 = u.pm * BM + wr * 64 + fr, col0 = u.pn * HALF + wc * 32 + 8 * fq;
#pragma unroll
        for (int ai = 0; ai < 2; ++ai)
#pragma unroll
            for (int m = 0; m < 4; ++m) { const int rr = row0 + ai * HALF + m * 16; bf16_t* rowp = O + ((size_t)(rr >> 8) * (ldc >> 6) + (col0 >> 6)) * 16384 + (rr & 255) * 64 + (col0 & 63);
                const f32x4 h0 = silu_mul4(acc[ai][0][m][0], acc[ai][1][m][0]), h1 = silu_mul4(acc[ai][0][m][1], acc[ai][1][m][1]);
                u32x4 w; w.x = cvt_pk_nv(h0[0], h0[1]); w.y = cvt_pk_nv(h0[2], h0[3]); w.z = cvt_pk_nv(h1[0], h1[1]); w.w = cvt_pk_nv(h1[2], h1[3]);
                __builtin_nontemporal_store(w, (u32x4*)rowp); }
    }
};

struct EpiRes {
    static constexpr bool PERM = false, AFTER_DRAIN = false; static constexpr int A_AUX = 2;
    const float* base_lat; const float* base_ctx; float* out_lat; float* out_ctx; const float* gate; float s; float* part;
    __device__ __forceinline__ void operator()(const f32x4 (&acc)[2][2][4][2], const Unit& u, int wr, int wc, int fr, int fq) const {
        if (u.ks >= 0) {
            float* pp = part + (size_t)u.ks * 1024 * 1024 + (size_t)(u.pm * BM - N_LAT + wr * 64 + fr) * D_MODEL + u.pn * BM + wc * 32 + 4 * fq;
#pragma unroll
            for (int ai = 0; ai < 2; ++ai)
#pragma unroll
                for (int m = 0; m < 4; ++m)
#pragma unroll
                    for (int bj = 0; bj < 2; ++bj)
#pragma unroll
                        for (int n = 0; n < 2; ++n) *(f32x4*)(pp + (size_t)(ai * HALF + m * 16) * D_MODEL + bj * HALF + n * 16) = acc[ai][bj][m][n];
            return;
        }
        const bool lat = u.pm < (N_LAT / BM);
        const int r5 = lat ? (u.pm >> 5) : 4;
        const float* g = gate + (size_t)r5 * MODROW;
        const int rowt = (lat ? u.pm * BM : u.pm * BM - N_LAT) + wr * 64 + fr;
        const float* bp = lat ? base_lat : base_ctx; float* op = lat ? out_lat : out_ctx;
        const int col0 = u.pn * BM + wc * 32 + 4 * fq;
        f32x4 gv[2][2];
#pragma unroll
        for (int bj = 0; bj < 2; ++bj)
#pragma unroll
            for (int n = 0; n < 2; ++n) gv[bj][n] = *(const f32x4*)(g + col0 + bj * HALF + n * 16) * s;
#pragma unroll
        for (int ai = 0; ai < 2; ++ai) {
            f32x4 b[4][2][2];
#pragma unroll
            for (int m = 0; m < 4; ++m) { const size_t off = (size_t)(rowt + ai * HALF + m * 16) * D_MODEL + col0;
#pragma unroll
                for (int bj = 0; bj < 2; ++bj)
#pragma unroll
                    for (int n = 0; n < 2; ++n) b[m][bj][n] = *(const f32x4*)(bp + off + bj * HALF + n * 16); }
#pragma unroll
            for (int m = 0; m < 4; ++m) { const size_t off = (size_t)(rowt + ai * HALF + m * 16) * D_MODEL + col0;
#pragma unroll
                for (int bj = 0; bj < 2; ++bj)
#pragma unroll
                    for (int n = 0; n < 2; ++n) *(f32x4*)(op + off + bj * HALF + n * 16) = b[m][bj][n] + gv[bj][n] * acc[ai][bj][m][n]; }
        }
    }
};

struct EpiQKV {
    static constexpr bool PERM = true, AFTER_DRAIN = false; static constexpr int A_AUX = 0;
    bf16_t* O; int ldc; const float* qn; const float* kn; const float* cosT; const float* sinT;
    __device__ __forceinline__ void operator()(const f32x4 (&acc)[2][2][4][2], const Unit& u, int wr, int wc, int fr, int fq) const {
        const int hd = u.pn * 4 + wc;
        const bool lat = u.pm < (N_LAT / BM);
        const bool rope = lat && (hd < 10 || hd == 16 || hd == 17 || hd == 20 || hd == 21);
        const bool qnorm = (hd >= 6 && hd < 10), knorm = (hd == 20 || hd == 21);
        const float qs = hd < 16 ? 0.125f * 1.4426950408889634f : 1.0f;
        const int row0 = u.pm * BM + wr * 64 + fr, col0 = u.pn * BM + wc * 64 + 8 * fq;
        f32x4 gn[2][2];
        if (qnorm || knorm) { const float* gp = (qnorm ? qn : kn) + 8 * fq;
#pragma unroll
            for (int bj = 0; bj < 2; ++bj)
#pragma unroll
                for (int n = 0; n < 2; ++n) gn[bj][n] = *(const f32x4*)(gp + bj * 32 + n * 4); }
#pragma unroll
        for (int am = 0; am < 4; ++am) { const int ai = am >> 1;
            f32x4 cs[4][2], sn[4][2];
            if (rope) {
#pragma unroll
                for (int m = 2 * (am & 1); m < 2 * (am & 1) + 2; ++m) { const int t = (row0 + ai * HALF + m * 16) & 8191;
#pragma unroll
                    for (int n = 0; n < 2; ++n) { cs[m][n] = *(const f32x4*)(cosT + t * 32 + 8 * fq + 4 * n); sn[m][n] = *(const f32x4*)(sinT + t * 32 + 8 * fq + 4 * n); } }
            }
#pragma unroll
            for (int m = 2 * (am & 1); m < 2 * (am & 1) + 2; ++m) {
                const int row = row0 + ai * HALF + m * 16;
                f32x4 x[2][2];
#pragma unroll
                for (int bj = 0; bj < 2; ++bj)
#pragma unroll
                    for (int n = 0; n < 2; ++n) x[bj][n] = acc[ai][bj][m][n];
                if (qnorm || knorm) {
                    float ss = 0.f;
#pragma unroll
                    for (int bj = 0; bj < 2; ++bj)
#pragma unroll
                        for (int n = 0; n < 2; ++n) ss += (x[bj][n][0] * x[bj][n][0] + x[bj][n][1] * x[bj][n][1]) + (x[bj][n][2] * x[bj][n][2] + x[bj][n][3] * x[bj][n][3]);
                    ss += __shfl_xor(ss, 16); ss += __shfl_xor(ss, 32);
                    const float rs = __builtin_amdgcn_rsqf(ss * (1.0f / 64.0f) + 1e-6f);
#pragma unroll
                    for (int bj = 0; bj < 2; ++bj)
#pragma unroll
                        for (int n = 0; n < 2; ++n) x[bj][n] = x[bj][n] * rs * gn[bj][n];
                }
                if (rope) {
#pragma unroll
                    for (int n = 0; n < 2; ++n) { const f32x4 c = cs[m][n], s = sn[m][n];
                        const f32x4 a = x[0][n], b = x[1][n]; x[0][n] = a * c - b * s; x[1][n] = b * c + a * s; }
                }
                bf16_t* rowp = O + (size_t)row * ldc + col0;
#pragma unroll
                for (int bj = 0; bj < 2; ++bj) { const f32x4 v0 = x[bj][0] * qs, v1 = x[bj][1] * qs;
                    u32x4 w; w.x = cvt_pk_bf16(v0[0], v0[1]); w.y = cvt_pk_bf16(v0[2], v0[3]); w.z = cvt_pk_bf16(v1[0], v1[1]); w.w = cvt_pk_bf16(v1[2], v1[3]);
                    *(u32x4*)(rowp + bj * 32) = w; }
            }
        }
    }
};

template <class Epi, class Sched, bool ALIGN_EPI = false, bool SP2 = false>
__device__ __forceinline__ void gemm_phase(PG8_LAS unsigned char* lds, const Gemm g, const Sched& S, const Epi& E) {
    int tid = threadIdx.x; asm volatile("" : "+v"(tid)); const int wid = __builtin_amdgcn_readfirstlane(tid >> 6), lane = tid & 63, wr = wid >> 2, wc = wid & 3, fr = lane & 15, fq = lane >> 4;
    const int K = g.K;
    unsigned voffA[2], voffB[2];
#pragma unroll
    for (int i = 0; i < 2; ++i) { int R, C; stage_rc(tid * 16 + i * 8192, R, C); const int Rb = Epi::PERM ? ((R & ~31) + perm32(R & 31)) : R;
        voffA[i] = (unsigned)(R * BK + C) * 2u; voffB[i] = (unsigned)(Rb * BK + C) * 2u; }
    const size_t kstep = (size_t)(BM * BK * 2);
    const size_t hstep = (size_t)HALF * BK * 2;
    const size_t tstep = (size_t)BM * K * 2;
    const unsigned ldsw = (unsigned)wid * 1024u;
    const int aoff = lds_byte(wr * 64 + fr, fq * 8), boff = lds_byte(wc * 32 + fr, fq * 8);
#define PG8_SA(b, h) (((b) * 2 + (h)) * HTB)
#define PG8_SB(b, h) ((4 + (b) * 2 + (h)) * HTB)
#define PG8_STAGE_X(bufoff, gbase, voff, AUX) do { _Pragma("unroll") for (int _i = 0; _i < 2; ++_i) \
        __builtin_amdgcn_global_load_lds((const unsigned*)((const char*)(gbase) + (voff)[_i]), (PG8_LAS unsigned*)(lds + (bufoff) + ldsw + _i * 8192), 16, 0, AUX); } while (0)
#define PG8_STAGE(bufoff, gbase, voff) PG8_STAGE_X(bufoff, gbase, voff, 0)
#define PG8_STAGE_A(bufoff, gbase, voff) PG8_STAGE_X(bufoff, gbase, voff, Epi::A_AUX)
#define PG8_LDA(dst, b, h) do { _Pragma("unroll") for (int m = 0; m < 4; ++m) _Pragma("unroll") for (int k = 0; k < 2; ++k) dst[m][k] = *(const PG8_LAS bf16x8*)(lds + PG8_SA(b, h) + aoff + m * 2048 + k * 1024); } while (0)
#define PG8_LDB(dst, b, h) do { _Pragma("unroll") for (int n = 0; n < 2; ++n) _Pragma("unroll") for (int k = 0; k < 2; ++k) dst[n][k] = *(const PG8_LAS bf16x8*)(lds + PG8_SB(b, h) + boff + n * 2048 + k * 1024); } while (0)
#define PG8_MMA(ai, bj, At, Bt) do { __builtin_amdgcn_s_setprio(1); _Pragma("unroll") for (int m = 0; m < 4; ++m) _Pragma("unroll") for (int n = 0; n < 2; ++n) _Pragma("unroll") for (int k = 0; k < 2; ++k) \
        acc[ai][bj][m][n] = __builtin_amdgcn_mfma_f32_16x16x32_bf16(Bt[n][k], At[m][k], acc[ai][bj][m][n], 0, 0, 0); __builtin_amdgcn_s_setprio(0); } while (0)
#define PG8_WAIT_V(n) asm volatile("s_waitcnt vmcnt(" #n ")" ::: "memory")
#define PG8_WAIT_L(n) asm volatile("s_waitcnt lgkmcnt(" #n ")" ::: "memory")
#define PG8_BAR __builtin_amdgcn_s_barrier()
#define PG8_SCHED __builtin_amdgcn_sched_barrier(0)
    Unit cur, nxt; int ui = 0;
    if (!S.next(0, cur)) return;
    f32x4 acc[2][2][4][2];
#pragma unroll
    for (int a = 0; a < 2; ++a)
#pragma unroll
        for (int b = 0; b < 2; ++b)
#pragma unroll
            for (int m = 0; m < 4; ++m)
#pragma unroll
                for (int n = 0; n < 2; ++n) acc[a][b][m][n] = (f32x4){0.f, 0.f, 0.f, 0.f};
    bf16x8 At[4][2], B0[2][2], B1[2][2];
    const char* cA = (const char*)g.A + (size_t)cur.pm * tstep + (size_t)cur.k0t * kstep; const char* cB = (const char*)g.Bt + (size_t)cur.pn * tstep + (size_t)cur.k0t * kstep;
    S.a_ready(cur);
    if constexpr (SP2) {
        PG8_STAGE(PG8_SB(0, 0), cB, voffB); PG8_STAGE(PG8_SB(0, 1), cB + hstep, voffB); PG8_STAGE_A(PG8_SA(0, 0), cA, voffA); PG8_STAGE_A(PG8_SA(0, 1), cA + hstep, voffA);
        if (wr == 1) PG8_BAR;
        PG8_WAIT_V(2); PG8_BAR;
        PG8_STAGE(PG8_SB(1, 0), cB + kstep, voffB); PG8_STAGE_A(PG8_SA(1, 0), cA + kstep, voffA); PG8_STAGE(PG8_SB(1, 1), cB + hstep + kstep, voffB);
        PG8_WAIT_V(6); PG8_BAR;
    } else {
        PG8_STAGE(PG8_SB(0, 0), cB, voffB); PG8_STAGE_A(PG8_SA(0, 0), cA, voffA); PG8_STAGE(PG8_SB(0, 1), cB + hstep, voffB); PG8_STAGE_A(PG8_SA(0, 1), cA + hstep, voffA);
        if (wr == 1) PG8_BAR;
        PG8_WAIT_V(4); PG8_BAR;
        PG8_STAGE(PG8_SB(1, 0), cB + kstep, voffB); PG8_STAGE_A(PG8_SA(1, 0), cA + kstep, voffA); PG8_STAGE(PG8_SB(1, 1), cB + hstep + kstep, voffB);
        PG8_WAIT_V(6); PG8_BAR;
    }
    for (;;) {
        const bool has_next = S.next(ui + 1, nxt);
        const char* nA = has_next ? (const char*)g.A + (size_t)nxt.pm * tstep + (size_t)nxt.k0t * kstep : cA; const char* nB = has_next ? (const char*)g.Bt + (size_t)nxt.pn * tstep + (size_t)nxt.k0t * kstep : cB;
        const int nt = cur.nt;
        for (int t = 0; t < nt; t += 2) {
            const bool last = (t == nt - 2);
            const char* a1 = cA + (size_t)(t + 1) * kstep;
            const char* a2 = last ? nA : cA + (size_t)(t + 2) * kstep; const char* b2 = last ? nB : cB + (size_t)(t + 2) * kstep;
            const char* a3 = a2 + kstep; const char* b3 = b2 + kstep;
            if (last && has_next) S.a_ready(nxt);
            if constexpr (SP2) {
            PG8_LDB(B0, 0, 0); PG8_LDB(B1, 0, 1); PG8_SCHED; PG8_LDA(At, 0, 0); PG8_STAGE_A(PG8_SA(1, 1), a1 + hstep, voffA);
            PG8_WAIT_V(8); PG8_WAIT_L(0); PG8_BAR; PG8_MMA(0, 0, At, B0); PG8_MMA(0, 1, At, B1); PG8_BAR; PG8_SCHED;
            PG8_LDA(At, 0, 1); PG8_STAGE(PG8_SB(0, 0), b2, voffB); PG8_STAGE(PG8_SB(0, 1), b2 + hstep, voffB); PG8_STAGE_A(PG8_SA(0, 0), a2, voffA);
            PG8_WAIT_V(8); PG8_WAIT_L(0); PG8_BAR; PG8_MMA(1, 0, At, B0); PG8_MMA(1, 1, At, B1); PG8_BAR; PG8_SCHED;
            PG8_LDB(B0, 1, 0); PG8_LDB(B1, 1, 1); PG8_SCHED; PG8_LDA(At, 1, 0); PG8_STAGE_A(PG8_SA(0, 1), a2 + hstep, voffA);
            PG8_WAIT_V(8); PG8_WAIT_L(0); PG8_BAR; PG8_MMA(0, 0, At, B0); PG8_MMA(0, 1, At, B1); PG8_BAR; PG8_SCHED;
            PG8_LDA(At, 1, 1); PG8_STAGE(PG8_SB(1, 0), b3, voffB); PG8_STAGE(PG8_SB(1, 1), b3 + hstep, voffB); PG8_STAGE_A(PG8_SA(1, 0), a3, voffA);
            PG8_WAIT_V(8); PG8_WAIT_L(0); PG8_BAR; PG8_MMA(1, 0, At, B0); PG8_MMA(1, 1, At, B1); PG8_BAR; PG8_SCHED;
            } else {
            PG8_LDB(B0, 0, 0); PG8_SCHED; PG8_LDA(At, 0, 0); PG8_STAGE_A(PG8_SA(1, 1), a1 + hstep, voffA);
            PG8_WAIT_L(8); PG8_BAR; PG8_WAIT_L(0); PG8_MMA(0, 0, At, B0); PG8_BAR; PG8_SCHED;
            PG8_LDB(B1, 0, 1); PG8_STAGE(PG8_SB(0, 0), b2, voffB);
            PG8_BAR; PG8_WAIT_L(0); PG8_MMA(0, 1, At, B1); PG8_BAR;
            PG8_LDA(At, 0, 1); PG8_STAGE_A(PG8_SA(0, 0), a2, voffA);
            PG8_BAR; PG8_WAIT_L(0); PG8_MMA(1, 0, At, B0); PG8_BAR; PG8_SCHED;
            PG8_STAGE(PG8_SB(0, 1), b2 + hstep, voffB);
            PG8_WAIT_V(6); PG8_BAR; PG8_MMA(1, 1, At, B1); PG8_BAR;
            PG8_LDB(B0, 1, 0); PG8_SCHED; PG8_LDA(At, 1, 0); PG8_STAGE_A(PG8_SA(0, 1), a2 + hstep, voffA);
            PG8_WAIT_L(8); PG8_BAR; PG8_WAIT_L(0); PG8_MMA(0, 0, At, B0); PG8_BAR; PG8_SCHED;
            PG8_LDB(B1, 1, 1); PG8_STAGE(PG8_SB(1, 0), b3, voffB);
            PG8_BAR; PG8_WAIT_L(0); PG8_MMA(0, 1, At, B1); PG8_BAR;
            PG8_LDA(At, 1, 1); PG8_STAGE_A(PG8_SA(1, 0), a3, voffA);
            PG8_BAR; PG8_WAIT_L(0); PG8_MMA(1, 0, At, B0); PG8_BAR; PG8_SCHED;
            PG8_STAGE(PG8_SB(1, 1), b3 + hstep, voffB);
            PG8_WAIT_V(6); PG8_BAR; PG8_MMA(1, 1, At, B1); PG8_BAR;
            }
        }
        if constexpr (ALIGN_EPI) { if (wr == 0) PG8_BAR; }
        if constexpr (!Epi::AFTER_DRAIN) { E(acc, cur, wr, wc, fr, fq); S.done(cur); }
        if (!has_next) break;
#pragma unroll
        for (int a = 0; a < 2; ++a)
#pragma unroll
            for (int b = 0; b < 2; ++b)
#pragma unroll
                for (int m = 0; m < 4; ++m)
#pragma unroll
                    for (int n = 0; n < 2; ++n) acc[a][b][m][n] = (f32x4){0.f, 0.f, 0.f, 0.f};
        cur = nxt; cA = nA; cB = nB; ++ui;
        if constexpr (ALIGN_EPI) { if (wr == 1) PG8_BAR; }
    }
    PG8_WAIT_V(0);
    if constexpr (!ALIGN_EPI) { if (wr == 0) PG8_BAR; }
    PG8_BAR;
    if constexpr (Epi::AFTER_DRAIN) { E.fused(acc, cur, wr, wc, fr, fq, lds, wid, lane); S.done(cur); }
#undef PG8_SA
#undef PG8_SB
#undef PG8_STAGE
#undef PG8_STAGE_A
#undef PG8_STAGE_X
#undef PG8_LDA
#undef PG8_LDB
#undef PG8_MMA
#undef PG8_WAIT_V
#undef PG8_WAIT_L
#undef PG8_BAR
#undef PG8_SCHED
}
}
namespace att {
#define ATT_LAS __attribute__((address_space(3)))
typedef unsigned short bf16_t;
typedef short bf16x8 __attribute__((ext_vector_type(8)));
typedef short s16x4 __attribute__((ext_vector_type(4)));
typedef float f32x16 __attribute__((ext_vector_type(16)));
typedef unsigned u32x4 __attribute__((ext_vector_type(4)));
typedef unsigned u32x2 __attribute__((ext_vector_type(2)));
constexpr int PITCH = 2304, YPITCH = 1024, NLAT = 32768;
constexpr float LOG2E = 1.4426950408889634f, NEGF = -1e30f;
constexpr int LDS_K = 0, LDS_V = 24576, LDS_TBL = 40960 + 256;
struct AUnit { int mode, qrow0, qpos0, qcol, kcol, vcol, crow0, lrow0, t_lo, t_hi, hb; float sink; };

__device__ __forceinline__ int clampi(int v, int lo, int hi) { return v < lo ? lo : (v > hi ? hi : v); }
__device__ __forceinline__ void decode(int v, const float* sink_l, AUnit& a) {
    a.sink = NEGF; a.hb = 0;
    if (v < 512) { const int xcd = v & 7, slot = (v >> 3) & 31, i = v >> 8, b = xcd >> 1, kvh = xcd & 1, hq = 2 * kvh + i;
        a.mode = 0; a.qrow0 = b * 8192 + slot * 256; a.qpos0 = slot * 256; a.qcol = 384 + 64 * hq; a.kcol = 1280 + 64 * kvh; a.vcol = 1408 + 64 * kvh;
        a.crow0 = NLAT + b * 256; a.lrow0 = b * 8192; a.t_lo = 0; a.t_hi = 128; return; }
    if (v < 1280) { const int w = v - 512, b = w / 192, r = w % 192, hq = r >> 5, qb = r & 31, kvh = hq / 3;
        a.mode = 1; a.qrow0 = b * 8192 + qb * 256; a.qpos0 = qb * 256; a.qcol = 64 * hq; a.kcol = 1024 + 64 * kvh; a.vcol = 1152 + 64 * kvh;
        a.crow0 = NLAT + b * 256; a.lrow0 = b * 8192; a.t_lo = (4 * qb - 2) < 0 ? 0 : (4 * qb - 2); a.t_hi = (4 * qb + 6) > 128 ? 128 : (4 * qb + 6);
        a.sink = sink_l[hq] * LOG2E; return; }
    if (v < 2048) { const int w = v - 1280, b = w / 192, r = w % 192, h = r >> 5, qb = r & 31, r0 = 4 * qb;
        a.mode = 2; a.qrow0 = b * 8192 + qb * 256; a.qpos0 = qb * 256; a.qcol = 640 + 64 * h; a.kcol = 1536 + 64 * h; a.vcol = 1920 + 64 * h;
        a.crow0 = NLAT + b * 256; a.lrow0 = b * 8192; a.t_lo = clampi(r0 - 4, 0, 120); a.t_hi = clampi(r0 - 1, 0, 120) + 8; a.hb = h; return; }
    { const int w = v - 2048, b = w >> 4, hh = w & 15;
        a.mode = 0; a.qrow0 = NLAT + b * 256; a.qpos0 = 0; a.qcol = 64 * hh; a.crow0 = NLAT + b * 256; a.lrow0 = 0; a.t_lo = 0; a.t_hi = 0;
        if (hh < 6) { const int kvh = hh / 3; a.kcol = 1024 + 64 * kvh; a.vcol = 1152 + 64 * kvh; a.sink = sink_l[hh] * LOG2E; }
        else if (hh < 10) { const int kvh = (hh - 6) >> 1; a.kcol = 1280 + 64 * kvh; a.vcol = 1408 + 64 * kvh; }
        else { const int h = hh - 10; a.kcol = 1536 + 64 * h; a.vcol = 1920 + 64 * h; } }
}
__device__ __forceinline__ unsigned pk_bf16(float lo, float hi) { unsigned r; asm volatile("v_cvt_pk_bf16_f32 %0, %1, %2" : "=v"(r) : "v"(lo), "v"(hi)); return r; }
__device__ __forceinline__ s16x4 vtr(const ATT_LAS unsigned char* p) { typedef short v4i16_t __attribute__((ext_vector_type(4)));
    return __builtin_bit_cast(s16x4, __builtin_amdgcn_ds_read_tr16_b64_v4i16((ATT_LAS v4i16_t*)p)); }
__device__ __forceinline__ int crow(int r, int hi) { return (r & 3) + 8 * (r >> 2) + 4 * hi; }

#define ATT_SB() __builtin_amdgcn_sched_barrier(0)
__device__ __forceinline__ float max3f(float x, float y, float z) { return __builtin_fmaxf(__builtin_fmaxf(x, y), z); }
__device__ __forceinline__ float rowmax32(const f32x16& p0, const f32x16& p1) {
    float x = max3f(p0[0], p0[1], p1[0]), y = max3f(p0[2], p0[3], p1[1]); x = max3f(x, p1[2], p1[3]);
#pragma unroll
    for (int r = 4; r < 16; r += 4) { x = max3f(x, p0[r], p0[r + 1]); y = max3f(y, p0[r + 2], p0[r + 3]); x = max3f(x, p1[r], p1[r + 1]); y = max3f(y, p1[r + 2], p1[r + 3]); }
    const float mm = __builtin_fmaxf(x, y);
    auto rr = __builtin_amdgcn_permlane32_swap(__float_as_uint(mm), __float_as_uint(mm), false, false);
    return __builtin_fmaxf(__uint_as_float(rr[0]), __uint_as_float(rr[1]));
}
__device__ __forceinline__ float halfsum(float v) { auto rr = __builtin_amdgcn_permlane32_swap(__float_as_uint(v), __float_as_uint(v), false, false); return __uint_as_float(rr[0]) + __uint_as_float(rr[1]); }

#define ATT_TROW(t) ((t) < 4 ? a.crow0 + 64 * (t) : a.lrow0 + 64 * (a.t_lo + (t) - 4))
#define ATT_KBUF(i) (lds + LDS_K + (i) * 8192)
#define ATT_VBUF(i) (lds + LDS_V + (i) * 8192)
#define ATT_LDK(dst, buf) do { _Pragma("unroll") for (int d0_ = 0; d0_ < 4; ++d0_) { dst[2 * d0_] = *(const ATT_LAS bf16x8*)((buf) + kfrag + d0_ * 2048); dst[2 * d0_ + 1] = *(const ATT_LAS bf16x8*)((buf) + kfrag + d0_ * 2048 + 512); } } while (0)
template <bool NOMAX>
__device__ __forceinline__ void pipe_tiles(const AUnit& a, const int NF, const bf16_t* kg, const bf16_t* vg, const bf16x8 (&qf)[4], ATT_LAS unsigned char* lds,
                                           const int koff, const int voff, const int kfrag, const int vlane, float& m, float& lsum, f32x16& o0, f32x16& o1) {
        const f32x16 zero16 = {};
        u32x4 kreg, vreg; bf16x8 kf[8]; f32x16 c0, c1, e0, e1;
        { const u32x4 k0 = *(const u32x4*)(kg + (size_t)ATT_TROW(0) * PITCH), k1 = *(const u32x4*)(kg + (size_t)ATT_TROW(1) * PITCH);
          *(ATT_LAS u32x4*)(ATT_KBUF(0) + koff) = k0; *(ATT_LAS u32x4*)(ATT_KBUF(1) + koff) = k1; }
        __syncthreads();
        kreg = *(const u32x4*)(kg + (size_t)ATT_TROW(2) * PITCH); vreg = *(const u32x4*)(vg + (size_t)ATT_TROW(0) * PITCH);
        ATT_LDK(kf, ATT_KBUF(0));
        c0 = (f32x16){}; c1 = (f32x16){};
#pragma unroll
        for (int d0 = 0; d0 < 4; ++d0) { c0 = __builtin_amdgcn_mfma_f32_32x32x16_bf16(kf[2 * d0], qf[d0], c0, 0, 0, 0); c1 = __builtin_amdgcn_mfma_f32_32x32x16_bf16(kf[2 * d0 + 1], qf[d0], c1, 0, 0, 0); }
        m = NOMAX ? 0.f : rowmax32(c0, c1);
#pragma unroll
        for (int r = 0; r < 16; ++r) { e0[r] = __builtin_amdgcn_exp2f(c0[r] - m); e1[r] = __builtin_amdgcn_exp2f(c1[r] - m); }
        ATT_LDK(kf, ATT_KBUF(1));
        *(ATT_LAS u32x4*)(ATT_KBUF(2) + koff) = kreg; *(ATT_LAS u32x4*)(ATT_VBUF(0) + voff) = vreg;
        __syncthreads();
        u32x4 kregB = kreg, vregB = vreg;
        kreg = *(const u32x4*)(kg + (size_t)ATT_TROW(3) * PITCH); vreg = *(const u32x4*)(vg + (size_t)ATT_TROW(1) * PITCH);
        int kb2 = 0;
#define ATT_PIN(x) asm volatile("" : "+v"(x))
#define ATT_STEP(t, KW, VW, KL, VL, E0, E1, C0, C1) do { \
            const bool ldk = ((t) + 2 < NF); \
              \
            if (ldk) *(ATT_LAS u32x4*)(ATT_KBUF(kb2) + koff) = KW; \
            *(ATT_LAS u32x4*)(ATT_VBUF((t) & 1) + voff) = VW; \
            if ((t) + 3 < NF) KL = *(const u32x4*)(kg + (size_t)ATT_TROW((t) + 3) * PITCH); \
            if ((t) + 1 < NF) VL = *(const u32x4*)(vg + (size_t)ATT_TROW((t) + 1) * PITCH); \
            const ATT_LAS unsigned char* vb = ATT_VBUF(((t) - 1) & 1) + vlane; \
            s16x4 vlo[4], vh4[4], wlo[4], wh4[4]; \
            _Pragma("unroll") for (int i = 0; i < 4; ++i) { vlo[i] = vtr(vb + i * 1024); vh4[i] = vtr(vb + i * 1024 + 512); } \
            ATT_SB(); \
            u32x4 pw[4]; float sacc = 0.f; \
            _Pragma("unroll") for (int i = 0; i < 8; ++i) { \
                const int d0 = i >> 1; \
                if (i & 1) C1 = __builtin_amdgcn_mfma_f32_32x32x16_bf16(kf[i], qf[d0], d0 == 0 ? zero16 : C1, 0, 0, 0); \
                else       C0 = __builtin_amdgcn_mfma_f32_32x32x16_bf16(kf[i], qf[d0], d0 == 0 ? zero16 : C0, 0, 0, 0); \
                _Pragma("unroll") for (int j = 0; j < 4; ++j) { const int f = 4 * i + j; sacc += (f < 16 ? E0[f & 15] : E1[f & 15]); } \
                ATT_PIN(sacc); \
                _Pragma("unroll") for (int j = 0; j < 2; ++j) { const int f = 4 * i + 2 * j; const float x0 = (f < 16 ? E0[f & 15] : E1[f & 15]), x1 = (f < 16 ? E0[(f + 1) & 15] : E1[(f + 1) & 15]); \
                    pw[(2 * i + j) >> 2][(2 * i + j) & 3] = pk_bf16(x0, x1); } \
                ATT_SB(); \
            } \
            lsum += sacc; \
            float fsc = 1.0f; bool resc = false; \
            if (!NOMAX) { const float rm = rowmax32(C0, C1) - m; resc = __any(rm > 8.0f); \
            if (resc) { const float dl = __builtin_fmaxf(rm, 0.f); m += dl; fsc = __builtin_amdgcn_exp2f(-dl); lsum *= fsc; } \
                _Pragma("unroll") for (int r = 0; r < 16; ++r) { C0[r] -= m; C1[r] -= m; } } \
            ATT_SB(); \
            _Pragma("unroll") for (int i = 0; i < 4; ++i) { wlo[i] = vtr(vb + 4096 + i * 1024); wh4[i] = vtr(vb + 4096 + i * 1024 + 512); }     \
            ATT_SB(); \
            _Pragma("unroll") for (int i = 0; i < 8; ++i) { \
                const int s = i & 3; const bf16x8 pa = __builtin_bit_cast(bf16x8, pw[s]); \
                if (i < 4) { const bf16x8 vf = (bf16x8){vlo[s][0], vlo[s][1], vlo[s][2], vlo[s][3], vh4[s][0], vh4[s][1], vh4[s][2], vh4[s][3]}; \
                    o0 = __builtin_amdgcn_mfma_f32_32x32x16_bf16(vf, pa, o0, 0, 0, 0); } \
                else { const bf16x8 vf = (bf16x8){wlo[s][0], wlo[s][1], wlo[s][2], wlo[s][3], wh4[s][0], wh4[s][1], wh4[s][2], wh4[s][3]}; \
                    o1 = __builtin_amdgcn_mfma_f32_32x32x16_bf16(vf, pa, o1, 0, 0, 0); } \
                if (i < 4) { _Pragma("unroll") for (int j = 0; j < 4; ++j) C0[4 * i + j] = __builtin_amdgcn_exp2f(C0[4 * i + j]); ATT_PIN(C0); } \
                else       { _Pragma("unroll") for (int j = 0; j < 4; ++j) C1[4 * i - 16 + j] = __builtin_amdgcn_exp2f(C1[4 * i - 16 + j]); ATT_PIN(C1); } \
                if (i >= 2 && i < 6) { const int d0 = i - 2; const ATT_LAS unsigned char* kb = ATT_KBUF(kb2 == 0 ? 2 : kb2 - 1); \
                    kf[2 * d0] = *(const ATT_LAS bf16x8*)(kb + kfrag + d0 * 2048); kf[2 * d0 + 1] = *(const ATT_LAS bf16x8*)(kb + kfrag + d0 * 2048 + 512); } \
                ATT_SB(); \
            } \
            if (!NOMAX && resc) { \
                _Pragma("unroll") for (int r = 0; r < 16; ++r) { o0[r] *= fsc; o1[r] *= fsc; } } \
            kb2 = (kb2 == 2) ? 0 : kb2 + 1; \
            __syncthreads(); \
        } while (0)
        for (int t = 1; t < NF; t += 2) {
            ATT_STEP(t, kreg, vreg, kregB, vregB, e0, e1, c0, c1);
            if (t + 1 < NF) ATT_STEP(t + 1, kregB, vregB, kreg, vreg, c0, c1, e0, e1);
        }
        if ((NF - 1) & 1) { e0 = c0; e1 = c1; }
#undef ATT_STEP
#undef ATT_PIN
        { u32x4 pw[4]; float sacc = 0.f;
#pragma unroll
          for (int r = 0; r < 16; ++r) sacc += e0[r] + e1[r];
          lsum += sacc;
#pragma unroll
          for (int j = 0; j < 4; ++j) { pw[0][j] = pk_bf16(e0[2 * j], e0[2 * j + 1]); pw[1][j] = pk_bf16(e0[8 + 2 * j], e0[8 + 2 * j + 1]);
                                        pw[2][j] = pk_bf16(e1[2 * j], e1[2 * j + 1]); pw[3][j] = pk_bf16(e1[8 + 2 * j], e1[8 + 2 * j + 1]); }
          const ATT_LAS unsigned char* vb = ATT_VBUF((NF - 1) & 1) + vlane;
#pragma unroll
          for (int s = 0; s < 4; ++s) { const bf16x8 pa = __builtin_bit_cast(bf16x8, pw[s]);
              { const s16x4 lo = vtr(vb + s * 1024), h4 = vtr(vb + s * 1024 + 512); const bf16x8 vf = (bf16x8){lo[0], lo[1], lo[2], lo[3], h4[0], h4[1], h4[2], h4[3]};
                o0 = __builtin_amdgcn_mfma_f32_32x32x16_bf16(vf, pa, o0, 0, 0, 0); }
              { const s16x4 lo = vtr(vb + 4096 + s * 1024), h4 = vtr(vb + 4096 + s * 1024 + 512); const bf16x8 vf = (bf16x8){lo[0], lo[1], lo[2], lo[3], h4[0], h4[1], h4[2], h4[3]};
                o1 = __builtin_amdgcn_mfma_f32_32x32x16_bf16(vf, pa, o1, 0, 0, 0); } }
        }
        __syncthreads();
}

__device__ __forceinline__ void attn_unit(int uv, const float* sink_l, const bf16_t* P, bf16_t* Y, ATT_LAS unsigned char* lds, const float* rpb_l, const float* qn_l, const float* kn_l) {
    AUnit a; decode(uv, sink_l, a);
    int tid = threadIdx.x; asm volatile("" : "+v"(tid)); const int lane = tid & 63, r32 = lane & 31, hi = lane >> 5; const int wid = __builtin_amdgcn_readfirstlane(tid >> 6);
    const int kkey = 8 * wid + (lane & 7), kc = lane >> 3;
    const int vkey = 8 * wid + ((lane >> 2) & 1) + 2 * ((lane >> 4) & 3), vd8 = (lane & 3) + 4 * ((lane >> 3) & 1);
    const int koff = (kc >> 1) * 2048 + (kc & 1) * 1024 + (kkey >> 5) * 512 + (kkey & 31) * 16;
    const int voff = (vd8 >> 2) * 4096 + (vkey >> 3) * 512 + (vkey & 7) * 64 + (vd8 & 3) * 16;
    const bf16_t* kg = P + (size_t)kkey * PITCH + a.kcol + kc * 8;
    const bf16_t* vg = P + (size_t)vkey * PITCH + a.vcol + vd8 * 8;
    ATT_LAS float* tbl = (ATT_LAS float*)(lds + LDS_TBL);
    if (a.mode == 2) { for (int i = tid; i < 465; i += 512) tbl[i] = rpb_l[a.hb * 465 + i] * LOG2E; }
    const int qrow = a.qrow0 + 32 * wid + r32;
    bf16x8 qf[4];
#pragma unroll
    for (int d0 = 0; d0 < 4; ++d0) qf[d0] = *(const bf16x8*)(P + (size_t)qrow * PITCH + a.qcol + 16 * d0 + 8 * hi);
    const int nlat = a.t_hi - a.t_lo;
    const int kfrag = hi * 1024 + r32 * 16;
    const int vlane = ((lane >> 4) & 1) * 32 + (lane & 3) * 8 + (4 * hi + ((lane & 15) >> 2)) * 64;
    float m, lsum = 0.f; f32x16 o0 = {}, o1 = {};
    {
        const int NF = 4 + (a.mode == 0 ? nlat : 0);
        bool nomax = false;
        if (uv < 512) {
            float gq = __builtin_fabsf(qn_l[lane]), gk = __builtin_fabsf(kn_l[lane]);
#pragma unroll
            for (int o = 1; o < 64; o <<= 1) { gq = __builtin_fmaxf(gq, __shfl_xor(gq, o)); gk = __builtin_fmaxf(gk, __shfl_xor(gk, o)); }
            nomax = __builtin_amdgcn_readfirstlane(__float_as_int(gq * gk * (8.0f * LOG2E))) < __float_as_int(40.0f);
        }
        if (nomax) pipe_tiles<true>(a, NF, kg, vg, qf, lds, koff, voff, kfrag, vlane, m, lsum, o0, o1);
        else       pipe_tiles<false>(a, NF, kg, vg, qf, lds, koff, voff, kfrag, vlane, m, lsum, o0, o1);
    }
    if (a.mode != 0 && nlat > 0) {
        u32x4 kreg, vreg;
        { const size_t ro = (size_t)ATT_TROW(4) * PITCH; kreg = *(const u32x4*)(kg + ro); vreg = *(const u32x4*)(vg + ro); }
        *(ATT_LAS u32x4*)(ATT_KBUF(0) + koff) = kreg; *(ATT_LAS u32x4*)(ATT_VBUF(0) + voff) = vreg;
        __syncthreads();
        const int qw = a.qpos0 + 32 * wid, qr = qw >> 6;
        for (int t = 0; t < nlat; ++t) {
            const int cur = t & 1, tl = a.t_lo + t;
            if (t + 1 < nlat) { const size_t ro = (size_t)ATT_TROW(t + 5) * PITCH; kreg = *(const u32x4*)(kg + ro); vreg = *(const u32x4*)(vg + ro); }
            bool need;
            if (a.mode == 1) need = (tl * 64 + 63 >= qw - 128) && (tl * 64 <= qw + 31 + 128);
            else { const int rs = clampi(qr - 4, 0, 120); need = (tl >= rs) && (tl < rs + 8); }
            if (need) {
                const ATT_LAS unsigned char* Kb = ATT_KBUF(cur); const ATT_LAS unsigned char* Vb = ATT_VBUF(cur);
                f32x16 p0 = {}, p1 = {};
#pragma unroll
                for (int d0 = 0; d0 < 4; ++d0) {
                    const bf16x8 k0 = *(const ATT_LAS bf16x8*)(Kb + kfrag + d0 * 2048);
                    const bf16x8 k1 = *(const ATT_LAS bf16x8*)(Kb + kfrag + d0 * 2048 + 512);
                    p0 = __builtin_amdgcn_mfma_f32_32x32x16_bf16(k0, qf[d0], p0, 0, 0, 0);
                    p1 = __builtin_amdgcn_mfma_f32_32x32x16_bf16(k1, qf[d0], p1, 0, 0, 0);
                }
                if (a.mode == 1) { const int dq = tl * 64 - (qw + r32);
#pragma unroll
                    for (int r = 0; r < 16; ++r) { const int d = dq + crow(r, hi); if (d > 128 || d < -128) p0[r] = NEGF; if (d + 32 > 128 || d + 32 < -128) p1[r] = NEGF; } }
                else { const int qc = 32 * (wid & 1) + r32, cs = clampi(qc - 8, 0, 48); const ATT_LAS float* trow = tbl + (tl - qr + 7) * 31 + 15 - qc;
#pragma unroll
                    for (int r = 0; r < 16; ++r) { const int kcl = crow(r, hi);
                        const float b0 = trow[kcl], b1 = trow[kcl + 32];
                        p0[r] = ((unsigned)(kcl - cs) < 16u) ? p0[r] + b0 : NEGF;
                        p1[r] = ((unsigned)(kcl + 32 - cs) < 16u) ? p1[r] + b1 : NEGF; } }
                const float mt = rowmax32(p0, p1);
                if (__any(mt > m)) { const float mn = fmaxf(m, mt), alpha = __builtin_amdgcn_exp2f(m - mn); m = mn; lsum *= alpha;
#pragma unroll
                    for (int r = 0; r < 16; ++r) { o0[r] *= alpha; o1[r] *= alpha; } }
                float sum = 0.f;
#pragma unroll
                for (int r = 0; r < 16; ++r) { p0[r] = __builtin_amdgcn_exp2f(p0[r] - m); p1[r] = __builtin_amdgcn_exp2f(p1[r] - m); sum += p0[r] + p1[r]; }
                lsum += sum;
                u32x4 pw[4];
#pragma unroll
                for (int j = 0; j < 4; ++j) { pw[0][j] = pk_bf16(p0[2 * j], p0[2 * j + 1]); pw[1][j] = pk_bf16(p0[8 + 2 * j], p0[8 + 2 * j + 1]);
                                              pw[2][j] = pk_bf16(p1[2 * j], p1[2 * j + 1]); pw[3][j] = pk_bf16(p1[8 + 2 * j], p1[8 + 2 * j + 1]); }
                const ATT_LAS unsigned char* vb = Vb + vlane;
#pragma unroll
                for (int s = 0; s < 4; ++s) {
                    const bf16x8 pa = __builtin_bit_cast(bf16x8, pw[s]);
                    { const s16x4 lo = vtr(vb + s * 1024), h4 = vtr(vb + s * 1024 + 512);
                      const bf16x8 vf = (bf16x8){lo[0], lo[1], lo[2], lo[3], h4[0], h4[1], h4[2], h4[3]};
                      o0 = __builtin_amdgcn_mfma_f32_32x32x16_bf16(vf, pa, o0, 0, 0, 0); }
                    { const s16x4 lo = vtr(vb + 4096 + s * 1024), h4 = vtr(vb + 4096 + s * 1024 + 512);
                      const bf16x8 vf = (bf16x8){lo[0], lo[1], lo[2], lo[3], h4[0], h4[1], h4[2], h4[3]};
                      o1 = __builtin_amdgcn_mfma_f32_32x32x16_bf16(vf, pa, o1, 0, 0, 0); }
                }
            }
            if (t + 1 < nlat) { *(ATT_LAS u32x4*)(ATT_KBUF(cur ^ 1) + koff) = kreg; *(ATT_LAS u32x4*)(ATT_VBUF(cur ^ 1) + voff) = vreg; }
            __syncthreads();
        }
    }
#undef ATT_TROW
#undef ATT_KBUF
#undef ATT_VBUF
#undef ATT_LDK
    lsum = halfsum(lsum);
    lsum += __builtin_amdgcn_exp2f(a.sink - m);
    const float inv = 1.0f / lsum;
    bf16_t* yr = Y + ((size_t)(qrow >> 8) * 16 + (a.qcol >> 6)) * 16384 + (qrow & 255) * 64 + 4 * hi;
#pragma unroll
    for (int g = 0; g < 4; ++g) {
        u32x2 w0, w1;
        w0.x = pk_bf16(o0[4 * g] * inv, o0[4 * g + 1] * inv); w0.y = pk_bf16(o0[4 * g + 2] * inv, o0[4 * g + 3] * inv);
        w1.x = pk_bf16(o1[4 * g] * inv, o1[4 * g + 1] * inv); w1.y = pk_bf16(o1[4 * g + 2] * inv, o1[4 * g + 3] * inv);
        *(u32x2*)(yr + 8 * g) = w0; *(u32x2*)(yr + 32 + 8 * g) = w1;
    }
}
}
#define LAS __attribute__((address_space(3)))
typedef unsigned short bf16;
typedef float f32x4 __attribute__((ext_vector_type(4)));
typedef unsigned v4u __attribute__((ext_vector_type(4)));
typedef unsigned v2u __attribute__((ext_vector_type(2)));
#ifndef NORM_REP
#define NORM_REP 1
#endif
#ifndef PRO_REP
#define PRO_REP 1
#endif
#ifndef SYNC_REP
#define SYNC_REP 1
#endif
#define GSYNC() do { unsigned oq_; asm volatile("s_mov_b32 %0, 0" : "=s"(oq_)); XcdBarrier xb_; xb_.bar = (unsigned*)(GASQ unsigned*)ldp_raw(lds0 + oq_, 23); xb_.x = xb_xcc_id(); xb_.st = (volatile LAS unsigned*)(lds0 + oq_ + MISC_OFF); for (int r_ = 0; r_ < SYNC_REP; ++r_) xcd_barrier(xb_); } while (0)
#ifndef G2_PMMASK
#define G2_PMMASK 0x7fffffff
#endif
#ifndef G2_REP
#define G2_REP 1
#endif
#ifndef G3_REP
#define G3_REP 1
#endif
#ifndef G1_REP
#define G1_REP 1
#endif
#ifndef ATT_EXTRA
#define ATT_EXTRA 0
#endif
#ifndef ATT_REP_N
#define ATT_REP_N 512
#endif
#ifndef PM
#define PM 127
#endif
constexpr int NWAVES = 8, NTHREADS = 512;
constexpr int D = 1024, FF = 2816, NLAT = 32768, NCTX = 1024, MFULL = NLAT + NCTX, WIN = 2304, MODROW = 9216, DEPTH = 2;
constexpr float EPS = 1e-6f;
constexpr size_t MiB = 1u << 20;
constexpr size_t WS_MOD = 1 * MiB, WS_COS = 2 * MiB, WS_SIN = 3 * MiB, WS_HC = 4 * MiB, WS_W = 8 * MiB;
constexpr size_t WL_GU1 = 0, WL_D1 = 11 * MiB, WL_IN = 16 * MiB + MiB / 2, WL_OUT = 21 * MiB, WL_GU2 = 23 * MiB, WL_D2 = 34 * MiB, WL_SIZE = 39 * MiB + MiB / 2;
constexpr size_t WS_U = 88 * MiB, WS_HID = 154 * MiB, WS_PART = 336 * MiB, WS_DUMMY = 352 * MiB, WS_END = 352 * MiB;
static_assert(WS_W + 2 * WL_SIZE <= WS_U && WS_U + (size_t)MFULL * D * 2 <= WS_HID && WS_HID + (size_t)MFULL * FF * 2 <= WS_PART, "ws map");
constexpr int LDS_BYTES = 147456;

__device__ __forceinline__ unsigned f2bf(float f) { unsigned u = __builtin_bit_cast(unsigned, f); return (u + 0x7fffu + ((u >> 16) & 1u)) >> 16; }
__device__ __forceinline__ unsigned pk2(float lo, float hi) { return f2bf(lo) | (f2bf(hi) << 16); }
__device__ __forceinline__ float wave_sum(float v) {
#pragma unroll
    for (int o = 1; o < 64; o <<= 1) v += __shfl_xor(v, o);
    return v;
}
__device__ __forceinline__ void transpose_item(const float* W, int K, int N, bf16* WT, int dst_row0, int k0, int n0, LAS float* scr, int lane) {
    f32x4 wv[8];
#pragma unroll
    for (int i = 0; i < 8; ++i) wv[i] = *(const f32x4*)(W + (size_t)(k0 + 8 * i + (lane >> 3)) * N + n0 + 4 * (lane & 7));
#pragma unroll
    for (int i = 0; i < 8; ++i) { LAS float* d = scr + (8 * i + (lane >> 3)) * 33 + 4 * (lane & 7); d[0] = wv[i][0]; d[1] = wv[i][1]; d[2] = wv[i][2]; d[3] = wv[i][3]; }
    asm volatile("s_waitcnt lgkmcnt(0)" ::: "memory");
    const int c = lane & 7;
#pragma unroll
    for (int j = 0; j < 4; ++j) { const int n = (lane >> 3) + 8 * j; const LAS float* s = scr + (8 * c) * 33 + n;
        v4u o; o.x = pk2(s[0 * 33], s[1 * 33]); o.y = pk2(s[2 * 33], s[3 * 33]); o.z = pk2(s[4 * 33], s[5 * 33]); o.w = pk2(s[6 * 33], s[7 * 33]);
        const int rr = dst_row0 + n; *(v4u*)(WT + ((size_t)(rr >> 8) * (K >> 6) + (k0 >> 6)) * 16384 + (rr & 255) * 64 + 8 * c) = o; }
    asm volatile("s_waitcnt lgkmcnt(0)" ::: "memory");
}

#define XB_TMO      128
#define XB_XCNT(j)  (256  + 64 * (j))
#define XB_XSUB(j)  (1280 + 64 * (j))
#define XB_XGEN(j)  (2304 + 64 * (j))
#define XB_TOP      3328
#define XB_TOPGEN   3392
#define XCD_BAR_WORDS 3456
#define XB_SPIN_CAP (1u << 18)

__device__ __forceinline__ unsigned xb_ld(unsigned* p)              { return __hip_atomic_load(p, __ATOMIC_RELAXED, __HIP_MEMORY_SCOPE_AGENT); }
__device__ __forceinline__ unsigned xb_add(unsigned* p, unsigned v) { return __hip_atomic_fetch_add(p, v, __ATOMIC_RELAXED, __HIP_MEMORY_SCOPE_AGENT); }
__device__ __forceinline__ unsigned xb_xcc_id() { return (unsigned)__builtin_amdgcn_s_getreg((3 << 11) | 20) & 0xFu; }
#define XB_SPIN(cond, bar) do { unsigned _sp = 0; while (cond) { __builtin_amdgcn_s_sleep(1); \
    if ((++_sp & 255u) == 0u) { if (xb_ld(&(bar)[XB_TMO])) break; if (_sp > XB_SPIN_CAP) { atomicAdd(&(bar)[XB_TMO], 1u); break; } } } } while (0)

struct XcdBarrier {
    unsigned* bar; unsigned x;
    volatile LAS unsigned* st;
};

__device__ __forceinline__ XcdBarrier xcd_barrier_post(unsigned* bar, volatile LAS unsigned* st) {
    XcdBarrier b; b.bar = bar; b.x = xb_xcc_id(); b.st = st;
    if (threadIdx.x == 0) (void)xb_add(&bar[XB_XCNT(b.x)], 1u);
    return b;
}
__device__ __forceinline__ void xcd_barrier_complete(unsigned* bar, unsigned x, unsigned& nloc, unsigned& nx) {
    const unsigned G = gridDim.x * gridDim.y * gridDim.z;
    unsigned sum, cnt, mine, sp = 0u;
    for (;;) {
        sum = 0u; cnt = 0u; mine = 0u;
#pragma unroll
        for (unsigned j = 0; j < 16; ++j) { const unsigned c = xb_ld(&bar[XB_XCNT(j)]); sum += c; cnt += (c > 0u) ? 1u : 0u; mine = (j == x) ? c : mine; }
        if (sum == G) break;
        __builtin_amdgcn_s_sleep(1);
        if ((++sp & 255u) == 0u) { if (xb_ld(&bar[XB_TMO])) break; if (sp > XB_SPIN_CAP) { atomicAdd(&bar[XB_TMO], 1u); break; } }
    }
    nloc = mine > 0u ? mine : 1u; nx = cnt > 0u ? cnt : 1u;
}

__device__ __forceinline__ void xcd_barrier(const XcdBarrier& b) {
    asm volatile("s_waitcnt vmcnt(0)" ::: "memory");
    __syncthreads();
    if (threadIdx.x == 0) {
        unsigned* bar = b.bar;
        __builtin_amdgcn_s_waitcnt(0);
        unsigned nloc = b.st[0], nx = b.st[1];
        if (nloc == 0u) { xcd_barrier_complete(bar, b.x, nloc, nx); b.st[0] = nloc; b.st[1] = nx; }
        const unsigned old = xb_add(&bar[XB_XSUB(b.x)], 1u);
        const unsigned gen = old / nloc;
        if (old + 1u == (gen + 1u) * nloc) {
            __builtin_amdgcn_fence(__ATOMIC_RELEASE, "agent");
            asm volatile("s_waitcnt vmcnt(0)" ::: "memory");
            const unsigned og = xb_add(&bar[XB_TOP], 1u);
            const unsigned tg = og / nx;
            if (og + 1u == (tg + 1u) * nx) xb_add(&bar[XB_TOPGEN], 1u);
            else XB_SPIN(xb_ld(&bar[XB_TOPGEN]) == tg, bar);
            __builtin_amdgcn_fence(__ATOMIC_ACQUIRE, "agent");
            xb_add(&bar[XB_XGEN(b.x)], 1u);
            asm volatile("s_waitcnt vmcnt(0)" ::: "memory");
        } else {
            XB_SPIN(xb_ld(&bar[XB_XGEN(b.x)]) == gen, bar);
            __builtin_amdgcn_fence(__ATOMIC_ACQUIRE, "agent");
            asm volatile("s_waitcnt vmcnt(0)" ::: "memory");
        }
    }
    __syncthreads();
}

struct Args { const float* in[22]; float* out; unsigned char* ws; };
constexpr int PTAB_OFF = 131072, MISC_OFF = 131072 + 256;
__device__ __forceinline__ unsigned long long ldp_raw(LAS unsigned char* lds, int i) { const unsigned long long v = ((volatile LAS unsigned long long*)(lds + PTAB_OFF))[i];
    const unsigned lo = __builtin_amdgcn_readfirstlane((unsigned)v), hi = __builtin_amdgcn_readfirstlane((unsigned)(v >> 32)); return ((unsigned long long)hi << 32) | lo; }
#define GASQ __attribute__((address_space(1)))
#define INP(i) ((const float*)(const GASQ float*)ldp_raw(lds, (i)))
#define OUTP ((float*)(GASQ float*)ldp_raw(lds, 22))
#define WSP ((unsigned char*)(GASQ unsigned char*)ldp_raw(lds, 23))

__device__ __forceinline__ void mod_task(const Args& A, int task, LAS float* ldsf, int tid) {
    const int l = task / 72, cb = task % 72;
    LAS float* sc = ldsf; LAS float* red = ldsf + 5120;
    for (int i = tid; i < 5120; i += NTHREADS) { const int r = i >> 10, k = i & 1023; const float x = r < 4 ? A.in[1][r * 1024 + k] : A.in[3][k]; sc[i] = x / (1.0f + __expf(-x)); }
    __syncthreads();
    const int quad = tid & 31, ks = tid >> 5;
    const float* W = A.in[4] + (size_t)l * D * MODROW + cb * 128 + quad * 4;
    f32x4 acc[5];
#pragma unroll
    for (int r = 0; r < 5; ++r) acc[r] = (f32x4){0.f, 0.f, 0.f, 0.f};
#pragma unroll 16
    for (int kk = 0; kk < 64; ++kk) { const int k = ks * 64 + kk; const f32x4 w = *(const f32x4*)(W + (size_t)k * MODROW);
#pragma unroll
        for (int r = 0; r < 5; ++r) acc[r] += w * sc[r * 1024 + k]; }
#pragma unroll
    for (int r = 0; r < 5; ++r) *(LAS f32x4*)(red + (ks * 5 + r) * 128 + quad * 4) = acc[r];
    __syncthreads();
    float* mod = (float*)(A.ws + WS_MOD);
    for (int i = tid; i < 640; i += NTHREADS) { const int r = i >> 7, col = i & 127; float s = 0.f;
#pragma unroll
        for (int k2 = 0; k2 < 16; ++k2) s += red[(k2 * 5 + r) * 128 + col];
        mod[(size_t)(l * 5 + r) * MODROW + cb * 128 + col] = s + A.in[5][l * MODROW + cb * 128 + col]; }
    __syncthreads();
}

__device__ __forceinline__ void norm_phase(const float* h_lat, const float* h_ctx, int M, const float* gain, const float* modl, int shift_idx, bf16* U, int gw, int ngw, int lane,
                                           const float* part, const float* pgate, float* hc_out) {
    for (int grp = gw; grp < M / 4; grp += ngw) {
        const int row = grp * 4;
        const float* xr = row < NLAT ? h_lat + (size_t)row * D : h_ctx + (size_t)(row - NLAT) * D;
        const int r5 = row < NLAT ? (row >> 13) : 4;
        const f32x4* sh = (const f32x4*)(modl + (size_t)r5 * MODROW + shift_idx * D) + lane; const f32x4* sc = sh + D / 4;
        const f32x4* x4 = (const f32x4*)xr + lane; const f32x4* g4 = (const f32x4*)gain + lane;
        f32x4 v[4][4]; float ss[4];
#pragma unroll
        for (int q = 0; q < 4; ++q)
#pragma unroll
            for (int j = 0; j < 4; ++j) v[q][j] = x4[q * (D / 4) + 64 * j];
        f32x4 gm[4], sf[4];
#pragma unroll
        for (int j = 0; j < 4; ++j) { gm[j] = g4[64 * j] * (sc[64 * j] + 1.0f); sf[j] = sh[64 * j]; }
        if (part != nullptr && row >= NLAT) {
            const f32x4* pg4 = (const f32x4*)pgate + lane;
#pragma unroll
            for (int q = 0; q < 4; ++q) { const f32x4* p4 = (const f32x4*)(part + (size_t)(row - NLAT + q) * D) + lane; f32x4* ho = (f32x4*)(hc_out + (size_t)(row - NLAT + q) * D) + lane;
#pragma unroll
                for (int j = 0; j < 4; ++j) { const f32x4 ps = (p4[64 * j] + p4[64 * j + 262144]) + (p4[64 * j + 2 * 262144] + p4[64 * j + 3 * 262144]);
                    v[q][j] += pg4[64 * j] * 0.5f * ps; ho[64 * j] = v[q][j]; } }
        }
#pragma unroll
        for (int q = 0; q < 4; ++q) { float a = 0.f;
#pragma unroll
            for (int j = 0; j < 4; ++j) a += (v[q][j][0] * v[q][j][0] + v[q][j][1] * v[q][j][1]) + (v[q][j][2] * v[q][j][2] + v[q][j][3] * v[q][j][3]);
            ss[q] = a; }
#pragma unroll
        for (int o = 1; o < 64; o <<= 1) {
#pragma unroll
            for (int q = 0; q < 4; ++q) ss[q] += __shfl_xor(ss[q], o); }
#pragma unroll
        for (int q = 0; q < 4; ++q) { const float rstd = 1.0f / sqrtf(ss[q] * (1.0f / D) + EPS);
            const int rr = row + q; bf16* ob = U + (size_t)(rr >> 8) * 16 * 16384 + (rr & 255) * 64 + (size_t)(lane >> 4) * 16384 + 4 * (lane & 15);
#pragma unroll
            for (int j = 0; j < 4; ++j) { const f32x4 y = v[q][j] * rstd * gm[j] + sf[j]; v2u w; w.x = pk2(y[0], y[1]); w.y = pk2(y[2], y[3]); *(v2u*)(ob + (size_t)j * 4 * 16384) = w; } }
    }
}

__global__ void __launch_bounds__(NTHREADS, 2) fwd_megakernel(Args A) {
    extern __shared__ __attribute__((aligned(16))) unsigned char lds_raw[];
    cg::grid_group grid = cg::this_grid();
    LAS unsigned char* lds0 = (LAS unsigned char*)lds_raw;
    const int wave = __builtin_amdgcn_readfirstlane(threadIdx.x >> 6);
    if (threadIdx.x == 0) { LAS unsigned long long* pt = (LAS unsigned long long*)(lds0 + PTAB_OFF);
#pragma unroll
        for (int i = 0; i < 22; ++i) pt[i] = (unsigned long long)A.in[i];
        pt[22] = (unsigned long long)A.out; pt[23] = (unsigned long long)A.ws;
        ((LAS unsigned*)(lds0 + MISC_OFF))[0] = 0u; ((LAS unsigned*)(lds0 + MISC_OFF))[1] = 0u; }
    __syncthreads();
    (void)xcd_barrier_post((unsigned*)A.ws, (volatile LAS unsigned*)(lds0 + MISC_OFF));

    for (int prep = 0; prep < PRO_REP; ++prep) {
        LAS unsigned char* lds = lds0; const int tid = threadIdx.x, lane = tid & 63;
        const int G = gridDim.x, bx = blockIdx.x, gw = bx * NWAVES + wave, ngw = G * NWAVES;
        unsigned char* ws = A.ws;
        float* cosT = (float*)(ws + WS_COS); float* sinT = (float*)(ws + WS_SIN);
        if (bx < 144) mod_task(A, bx, (LAS float*)lds, tid);
        for (int i = bx * NTHREADS + tid; i < 8192 * 32; i += G * NTHREADS) { const int t = i >> 5, j = i & 31; const float pos = (float)(j < 16 ? (t >> 6) : (t & 63));
            const float inv = exp2f(-(float)(j & 15) * (13.287712379549449f / 16.0f)); float rev = pos * inv * 0.15915494309189535f; rev -= floorf(rev);
            cosT[i] = __builtin_amdgcn_cosf(rev); sinT[i] = __builtin_amdgcn_sinf(rev); }
        LAS float* scr = (LAS float*)(lds + wave * 16384);
        constexpr int I_G = (D / 64) * (FF / 32), I_D = (FF / 64) * (D / 32), I_IN = (D / 64) * (WIN / 32), I_O = (D / 64) * (D / 32);
        constexpr int PER_L = 2 * (2 * I_G + I_D) + I_IN + I_O;
        for (int it = gw; it < DEPTH * PER_L; it += ngw) {
            const int l = it / PER_L; int r = it % PER_L; unsigned char* wl = ws + WS_W + (size_t)l * WL_SIZE;
            if (r < 2 * (2 * I_G + I_D)) {
                const int f = r / (2 * I_G + I_D); r -= f * (2 * I_G + I_D);
                bf16* gu = (bf16*)(wl + (f ? WL_GU2 : WL_GU1)); bf16* dn = (bf16*)(wl + (f ? WL_D2 : WL_D1));
                if (r < 2 * I_G) { const int up = r / I_G; r -= up * I_G; const int nb = FF / 32, kb = r / nb, n0 = (r % nb) * 32;
                    const float* W = (f ? (up ? A.in[19] : A.in[18]) : (up ? A.in[8] : A.in[7])) + (size_t)l * D * FF;
                    transpose_item(W, D, FF, gu, 256 * (n0 >> 7) + (n0 & 127) + 128 * up, kb * 64, n0, scr, lane); }
                else { r -= 2 * I_G; const int nb = D / 32, kb = r / nb, n0 = (r % nb) * 32;
                    const float* W = (f ? A.in[20] : A.in[9]) + (size_t)l * FF * D;
                    transpose_item(W, FF, D, dn, n0, kb * 64, n0, scr, lane); }
            } else { r -= 2 * (2 * I_G + I_D);
                if (r < I_IN) { const int nb = WIN / 32, kb = r / nb, n0 = (r % nb) * 32; const int nl = n0 & 255;
                    const float* W = A.in[11] + (size_t)l * D * WIN;
                    transpose_item(W, D, WIN, (bf16*)(wl + WL_IN), (n0 & ~255) + 128 * ((nl & 63) >> 5) + 32 * (nl >> 6), kb * 64, n0, scr, lane); }
                else { r -= I_IN; const int nb = D / 32, kb = r / nb, n0 = (r % nb) * 32;
                    const float* W = A.in[16] + (size_t)l * D * D;
                    transpose_item(W, D, D, (bf16*)(wl + WL_OUT), n0, kb * 64, n0, scr, lane); }
            }
        }
        if (PRO_REP > 1) __syncthreads();
    }
    if (gridDim.x == 0x7fffffffu) grid.sync();
    GSYNC();

#define GW_DECL unsigned opq_; asm volatile("s_mov_b32 %0, 0" : "=s"(opq_)); LAS unsigned char* lds = lds0 + opq_; int lane = (int)(threadIdx.x & 63); asm volatile("" : "+v"(lane)); int G = gridDim.x, bx = blockIdx.x; asm volatile("" : "+s"(G), "+s"(bx)); int wave = __builtin_amdgcn_readfirstlane(threadIdx.x >> 6); asm volatile("" : "+s"(wave)); unsigned char* ws = WSP
#define NORM_ARGS const int gw = bx * NWAVES + wave, ngw = G * NWAVES
#pragma unroll 1
    for (int l = 0; l < DEPTH; ++l) {
        { GW_DECL; NORM_ARGS; const float* src_lat = l == 0 ? INP(0) : (const float*)OUTP; const float* src_ctx = l == 0 ? INP(2) : (const float*)(ws + WS_HC);
          for (int nrep = 0; nrep < NORM_REP; ++nrep) norm_phase(src_lat, src_ctx, MFULL, INP(6) + l * D, (const float*)(ws + WS_MOD) + (size_t)l * 5 * MODROW, 0, (bf16*)(ws + WS_U), gw, ngw, lane,
                     l == 0 ? (const float*)nullptr : (const float*)(ws + WS_PART), (const float*)(ws + WS_MOD) + 4 * MODROW + 8 * D, (float*)(ws + WS_HC)); }
        GSYNC();
#if PM & 1
        { GW_DECL; pg8::Gemm g{(const bf16*)(ws + WS_U), (const bf16*)(ws + WS_W + (size_t)l * WL_SIZE + WL_GU1), MFULL, 2 * FF, D}; pg8::StaticOrder S; S.init(MFULL, 2 * FF, G, bx, D);
          pg8::EpiSwiGLU E{(bf16*)(ws + WS_HID), FF}; pg8::gemm_phase<pg8::EpiSwiGLU, pg8::StaticOrder, true, true>(lds, g, S, E); }
#endif
        GSYNC();
#if PM & 2
        for (int rep = 0; rep < ((l == 0) ? G2_REP : 1); ++rep)
        { GW_DECL; float* hl = OUTP; float* hc = (float*)(ws + WS_HC); const float* src_lat = l == 0 ? INP(0) : (const float*)hl; const float* src_ctx = l == 0 ? INP(2) : (const float*)hc;
          pg8::Gemm g{(const bf16*)(ws + WS_HID), (const bf16*)(ws + WS_W + (size_t)l * WL_SIZE + WL_D1), MFULL, D, FF}; pg8::CtxSplitOrder S; S.init(G, bx, FF, 64, NLAT, 0, rep ? G2_PMMASK : 0x7fffffff);
          pg8::EpiRes E{src_lat, src_ctx, rep ? (float*)(ws + WS_DUMMY) : hl, hc, (const float*)(ws + WS_MOD) + (size_t)l * 5 * MODROW + 2 * D, 0.5f, (float*)(ws + WS_PART)}; pg8::gemm_phase<pg8::EpiRes, pg8::CtxSplitOrder, true, true>(lds, g, S, E); }
#endif
        GSYNC();
        { GW_DECL; NORM_ARGS;
          for (int nrep = 0; nrep < NORM_REP; ++nrep) norm_phase(OUTP, l == 0 ? INP(2) : (const float*)(ws + WS_HC), MFULL, INP(10) + l * D, (const float*)(ws + WS_MOD) + (size_t)l * 5 * MODROW, 3, (bf16*)(ws + WS_U), gw, ngw, lane,
                     (const float*)(ws + WS_PART), (const float*)(ws + WS_MOD) + (size_t)l * 5 * MODROW + 4 * MODROW + 2 * D, (float*)(ws + WS_HC)); }
        GSYNC();
#if PM & 4
        for (int rep = 0; rep < ((l == 0) ? G3_REP : 1); ++rep)
        { GW_DECL; pg8::Gemm g{(const bf16*)(ws + WS_U), (const bf16*)(ws + WS_W + (size_t)l * WL_SIZE + WL_IN), MFULL, WIN, D}; pg8::StaticOrder S; S.init(MFULL, WIN, G, bx, D);
          pg8::EpiQKV E{(bf16*)(ws + WS_HID), WIN, INP(12) + l * 64, INP(13) + l * 64, (const float*)(ws + WS_COS), (const float*)(ws + WS_SIN)};
          pg8::gemm_phase<pg8::EpiQKV, pg8::StaticOrder, true, true>(lds, g, S, E); }
#endif
        GSYNC();
#if PM & 8
        { GW_DECL; const int nunits = (l == DEPTH - 1) ? 2048 : 2112; const float* sink_l = INP(14) + l * 6; const float* rpb_l = INP(15) + (size_t)l * 6 * 465; const float* qn_l = INP(12) + l * 64; const float* kn_l = INP(13) + l * 64;
          const bf16* P = (const bf16*)(ws + WS_HID); bf16* Y = (bf16*)(ws + WS_U);
#pragma unroll 1
          for (int v = bx; v < nunits + ATT_EXTRA; v += G) att::attn_unit(v < nunits ? v : v - nunits, sink_l, P, Y, lds, rpb_l, qn_l, kn_l); }
#endif
        GSYNC();
#if PM & 16
        { GW_DECL; const int M2 = (l == DEPTH - 1) ? NLAT : MFULL; float* hl = OUTP; float* hc = (float*)(ws + WS_HC);
          pg8::Gemm g{(const bf16*)(ws + WS_U), (const bf16*)(ws + WS_W + (size_t)l * WL_SIZE + WL_OUT), M2, D, D}; pg8::StaticOrder S; S.init(M2, D, G, bx, D);
          pg8::EpiRes E{hl, hc, hl, hc, (const float*)(ws + WS_MOD) + (size_t)l * 5 * MODROW + 5 * D, 1.0f, nullptr}; pg8::gemm_phase<pg8::EpiRes, pg8::StaticOrder, true, true>(lds, g, S, E); }
#endif
        GSYNC();
        { GW_DECL; NORM_ARGS; const int M2 = (l == DEPTH - 1) ? NLAT : MFULL;
          for (int nrep = 0; nrep < NORM_REP; ++nrep) norm_phase(OUTP, (const float*)(ws + WS_HC), M2, INP(17) + l * D, (const float*)(ws + WS_MOD) + (size_t)l * 5 * MODROW, 6, (bf16*)(ws + WS_U), gw, ngw, lane, (const float*)nullptr, (const float*)nullptr, (float*)nullptr); }
        GSYNC();
#if PM & 32
        { GW_DECL; const int M2 = (l == DEPTH - 1) ? NLAT : MFULL;
          pg8::Gemm g{(const bf16*)(ws + WS_U), (const bf16*)(ws + WS_W + (size_t)l * WL_SIZE + WL_GU2), M2, 2 * FF, D}; pg8::StaticOrder S; S.init(M2, 2 * FF, G, bx, D);
          pg8::EpiSwiGLU E{(bf16*)(ws + WS_HID), FF}; pg8::gemm_phase<pg8::EpiSwiGLU, pg8::StaticOrder, true, true>(lds, g, S, E); }
#endif
        GSYNC();
#if PM & 64
        { GW_DECL; const int M2 = (l == DEPTH - 1) ? NLAT : MFULL; float* hl = OUTP; float* hc = (float*)(ws + WS_HC);
          pg8::Gemm g{(const bf16*)(ws + WS_HID), (const bf16*)(ws + WS_W + (size_t)l * WL_SIZE + WL_D2), M2, D, FF}; pg8::CtxSplitOrder S; S.init(G, bx, FF, M2 == MFULL ? 64 : 0, NLAT, 0, 0x7fffffff);
          pg8::EpiRes E{hl, hc, hl, hc, (const float*)(ws + WS_MOD) + (size_t)l * 5 * MODROW + 8 * D, 0.5f, (float*)(ws + WS_PART)}; pg8::gemm_phase<pg8::EpiRes, pg8::CtxSplitOrder, true, true>(lds, g, S, E); }
#endif
        GSYNC();
    }
    { GW_DECL; NORM_ARGS; float* hl = OUTP; const float* gf = INP(21); (void)ws;
      for (int grp = gw; grp < NLAT / 4; grp += ngw) {
        f32x4* x4 = (f32x4*)(hl + (size_t)grp * 4 * D) + lane; const f32x4* g4 = (const f32x4*)gf + lane;
        f32x4 v[4][4]; float ss[4];
#pragma unroll
        for (int q = 0; q < 4; ++q)
#pragma unroll
            for (int j = 0; j < 4; ++j) v[q][j] = x4[q * (D / 4) + 64 * j];
#pragma unroll
        for (int q = 0; q < 4; ++q) { float a = 0.f;
#pragma unroll
            for (int j = 0; j < 4; ++j) a += (v[q][j][0] * v[q][j][0] + v[q][j][1] * v[q][j][1]) + (v[q][j][2] * v[q][j][2] + v[q][j][3] * v[q][j][3]);
            ss[q] = a; }
#pragma unroll
        for (int o = 1; o < 64; o <<= 1) {
#pragma unroll
            for (int q = 0; q < 4; ++q) ss[q] += __shfl_xor(ss[q], o); }
#pragma unroll
        for (int q = 0; q < 4; ++q) { const float rstd = 1.0f / sqrtf(ss[q] * (1.0f / D) + EPS);
#pragma unroll
            for (int j = 0; j < 4; ++j) x4[q * (D / 4) + 64 * j] = v[q][j] * rstd * g4[64 * j]; }
      } }
}

extern "C" void kernel_launch(void* const* d_in, const int* in_sizes, int n_in, void* d_out, int out_size, void* d_ws, size_t ws_size, hipStream_t stream) {
    static int grid_blocks = 0;
    if (grid_blocks == 0) {
        if (n_in != 22 || out_size != NLAT * D || ws_size < WS_END) { fprintf(stderr, "kernel_launch: unexpected shapes (n_in %d out %d ws %zu)\n", n_in, out_size, ws_size); grid_blocks = -1; return; }
        int dev = 0, cus = 0, per_cu = 0;
        hipGetDevice(&dev); hipDeviceGetAttribute(&cus, hipDeviceAttributeMultiprocessorCount, dev);
        if (hipFuncSetAttribute((const void*)fwd_megakernel, hipFuncAttributeMaxDynamicSharedMemorySize, LDS_BYTES) != hipSuccess) { fprintf(stderr, "hipFuncSetAttribute failed\n"); grid_blocks = -1; return; }
        if (hipOccupancyMaxActiveBlocksPerMultiprocessor(&per_cu, (const void*)fwd_megakernel, NTHREADS, LDS_BYTES) != hipSuccess || per_cu < 1) per_cu = 1;
        (void)hipGetLastError();
        grid_blocks = cus * per_cu;
        fprintf(stderr, "kernel_launch: %d CUs x %d = grid %d\n", cus, per_cu, grid_blocks);
    }
    if (grid_blocks < 0) return;
    if (hipMemsetAsync(d_ws, 0, 65536, stream) != hipSuccess) { fprintf(stderr, "memset failed\n"); return; }
    Args a{};
    for (int i = 0; i < 22; ++i) a.in[i] = (const float*)d_in[i];
    a.out = (float*)d_out; a.ws = (unsigned char*)d_ws;
    void* args[] = {&a};
    hipError_t e = hipLaunchCooperativeKernel((const void*)fwd_megakernel, dim3(grid_blocks), dim3(NTHREADS), args, LDS_BYTES, stream);
    if (e != hipSuccess) fprintf(stderr, "cooperative launch failed: %s (grid %d)\n", hipGetErrorString(e), grid_blocks);
}
```

```cpp
#include <hip/hip_runtime.h>
#include <hip/hip_cooperative_groups.h>
#include <cstdio>
#include <cstdint>
namespace cg = cooperative_groups;
namespace pg8 {
#define PG8_LAS __attribute__((address_space(3)))
typedef unsigned short bf16_t;
typedef short bf16x8 __attribute__((ext_vector_type(8)));
typedef float f32x4 __attribute__((ext_vector_type(4)));
typedef unsigned u32x4 __attribute__((ext_vector_type(4)));
constexpr int BM = 256, BK = 64, HALF = 128, HTB = HALF * BK * 2  , STAGE_BYTES = 8 * HTB, NXCD = 8, WGM = 8;

__host__ __device__ __forceinline__ int lds_byte(int r, int c) { const int st = (r >> 4) * 2 + (c >> 5), rr = r & 15, cc = c & 31, ob = rr * 64 + cc * 2; return st * 1024 + (ob ^ (((ob >> 9) & 1) << 5)); }
__host__ __device__ __forceinline__ void stage_rc(int b, int& R, int& C) { const int st = b / 1024, sb = b % 1024, swz = sb ^ (((sb >> 9) & 1) << 5); R = (st >> 1) * 16 + swz / 64; C = (st & 1) * 32 + (swz % 64) / 2; }
__host__ __device__ __forceinline__ int perm32(int rho) { const int n = rho >> 4, i = rho & 15; return 8 * (i >> 2) + 4 * n + (i & 3); }

struct Unit { int pm, pn, k0t, nt, ks; };
struct Gemm { const bf16_t* A; const bf16_t* Bt; int M, N, K; };

struct StaticOrder {
    int nM, nN, nwg, G, c, ntk, pmoff;
    __host__ __device__ __forceinline__ void init(int M, int N, int G_, int c_, int K_, int pmoff_ = 0) { nM = M / BM; nN = N / BM; nwg = nM * nN; G = G_; c = c_; ntk = K_ / BK; pmoff = pmoff_; }
    __host__ __device__ __forceinline__ bool next(int i, Unit& u) const {
        const long L = (long)i * G + c; if (L >= nwg) return false;
        int wgid = (int)L; { const int q = nwg / NXCD, r = nwg % NXCD, xcd = wgid % NXCD, off = wgid / NXCD; wgid = (xcd < r ? xcd * (q + 1) : r * (q + 1) + (xcd - r) * q) + off; }
        const int nig = WGM * nN, gid = wgid / nig, fm = gid * WGM, gsz = (nM - fm) < WGM ? (nM - fm) : WGM;
        u.pm = pmoff + fm + ((wgid % nig) % gsz); u.pn = (wgid % nig) / gsz; u.k0t = 0; u.nt = ntk; u.ks = -1; return true;
    }
    __device__ __forceinline__ void a_ready(const Unit&) const {}
    __device__ __forceinline__ void done(const Unit&) const {}
};

#ifndef REV_ORDER
#define REV_ORDER 1
#endif
struct CtxSplitOrder {
    StaticOrder lat; int G, c, nsub, pmmask;
    __host__ __device__ __forceinline__ void init(int G_, int c_, int K_, int nsub_, int latM, int pmoff_, int pmmask_) { lat.init(latM, 1024, G_, c_, K_, pmoff_); G = G_; c = c_; nsub = nsub_; pmmask = pmmask_; }
    __host__ __device__ __forceinline__ bool next(int i, Unit& u) const {
        const int L = i * G + c; const bool islat = L < lat.nwg;
        const int Ll = islat ? L : 0;
        int wgid = Ll; { const int q = lat.nwg / NXCD, r = lat.nwg % NXCD, xcd = wgid % NXCD, off = wgid / NXCD; wgid = (xcd < r ? xcd * (q + 1) : r * (q + 1) + (xcd - r) * q) + off; }
        wgid = REV_ORDER ? (lat.nwg - 1 - wgid) : wgid;
        const int nig = WGM * lat.nN, gid = wgid / nig, fm = gid * WGM, gsz = (lat.nM - fm) < WGM ? (lat.nM - fm) : WGM;
        const int lpm = lat.pmoff + fm + ((wgid % nig) % gsz), lpn = (wgid % nig) / gsz;
        const int j = islat ? 0 : L - lat.nwg, ks = j & 3;
        u.pm = islat ? (lpm & pmmask) : 128 + (j >> 4); u.pn = islat ? lpn : (j >> 2) & 3; u.ks = islat ? -1 : ks;
        u.k0t = islat ? 0 : ks * 12 - (ks == 3 ? 2 : 0); u.nt = islat ? lat.ntk : 12 - 2 * (ks >> 1);
        return islat || (L - lat.nwg) < nsub;
    }
    __device__ __forceinline__ void a_ready(const Unit&) const {}
    __device__ __forceinline__ void done(const Unit&) const {}
};

__device__ __forceinline__ unsigned cvt_pk_bf16(float lo, float hi) { unsigned r; asm volatile("v_cvt_pk_bf16_f32 %0, %1, %2" : "=v"(r) : "v"(lo), "v"(hi)); return r; }
typedef float f32x2 __attribute__((ext_vector_type(2)));
constexpr int D_MODEL = 1024, N_LAT = 32768, MODROW = 9216;
__device__ __forceinline__ unsigned cvt_pk_nv(float lo, float hi) { unsigned r; asm("v_cvt_pk_bf16_f32 %0, %1, %2" : "=v"(r) : "v"(lo), "v"(hi)); return r; }
__device__ __forceinline__ float silu_mul(float g, float u) { return g * __builtin_amdgcn_rcpf(1.0f + __builtin_amdgcn_exp2f(-1.4426950408889634f * g)) * u; }

__device__ __forceinline__ f32x4 silu_mul4(f32x4 g, f32x4 u) {
    f32x4 t = g * (-1.4426950408889634f), gu = g * u;
#pragma unroll
    for (int i = 0; i < 4; ++i) t[i] = __builtin_amdgcn_exp2f(t[i]);
    t = t + 1.0f;
#pragma unroll
    for (int i = 0; i < 4; ++i) t[i] = __builtin_amdgcn_rcpf(t[i]);
    return gu * t;
}
struct EpiSwiGLU {
    static constexpr bool PERM = true, AFTER_DRAIN = false;
    bf16_t* O; int ldc;
    __device__ __forceinline__ void operator()(const f32x4 (&acc)[2][2][4][2], const Unit& u, int wr, int wc, int fr, int fq) const {
        const int row0 = u.pm * BM + wr * 64 + fr, col0 = u.pn * HALF + wc * 32 + 8 * fq;
#pragma unroll
        for (int ai = 0; ai < 2; ++ai)
#pragma unroll
            for (int m = 0; m < 4; ++m) { const int rr = row0 + ai * HALF + m * 16; bf16_t* rowp = O + ((size_t)(rr >> 8) * (ldc >> 6) + (col0 >> 6)) * 16384 + (rr & 255) * 64 + (col0 & 63);
                const f32x4 h0 = silu_mul4(acc[ai][0][m][0], acc[ai][1][m][0]), h1 = silu_mul4(acc[ai][0][m][1], acc[ai][1][m][1]);
                u32x4 w; w.x = cvt_pk_nv(h0[0], h0[1]); w.y = cvt_pk_nv(h0[2], h0[3]); w.z = cvt_pk_nv(h1[0], h1[1]); w.w = cvt_pk_nv(h1[2], h1[3]);
                __builtin_nontemporal_store(w, (u32x4*)rowp); }
    }
};

struct EpiRes {
    static constexpr bool PERM = false, AFTER_DRAIN = false;
    const float* base_lat; const float* base_ctx; float* out_lat; float* out_ctx; const float* gate; float s; float* part;
    __device__ __forceinline__ void operator()(const f32x4 (&acc)[2][2][4][2], const Unit& u, int wr, int wc, int fr, int fq) const {
        if (u.ks >= 0) {
            float* pp = part + (size_t)u.ks * 1024 * 1024 + (size_t)(u.pm * BM - N_LAT + wr * 64 + fr) * D_MODEL + u.pn * BM + wc * 32 + 4 * fq;
#pragma unroll
            for (int ai = 0; ai < 2; ++ai)
#pragma unroll
                for (int m = 0; m < 4; ++m)
#pragma unroll
                    for (int bj = 0; bj < 2; ++bj)
#pragma unroll
                        for (int n = 0; n < 2; ++n) *(f32x4*)(pp + (size_t)(ai * HALF + m * 16) * D_MODEL + bj * HALF + n * 16) = acc[ai][bj][m][n];
            return;
        }
        const bool lat = u.pm < (N_LAT / BM);
        const int r5 = lat ? (u.pm >> 5) : 4;
        const float* g = gate + (size_t)r5 * MODROW;
        const int rowt = (lat ? u.pm * BM : u.pm * BM - N_LAT) + wr * 64 + fr;
        const float* bp = lat ? base_lat : base_ctx; float* op = lat ? out_lat : out_ctx;
        const int col0 = u.pn * BM + wc * 32 + 4 * fq;
        f32x4 gv[2][2];
#pragma unroll
        for (int bj = 0; bj < 2; ++bj)
#pragma unroll
            for (int n = 0; n < 2; ++n) gv[bj][n] = *(const f32x4*)(g + col0 + bj * HALF + n * 16) * s;
#pragma unroll
        for (int ai = 0; ai < 2; ++ai) {
            f32x4 b[4][2][2];
#pragma unroll
            for (int m = 0; m < 4; ++m) { const size_t off = (size_t)(rowt + ai * HALF + m * 16) * D_MODEL + col0;
#pragma unroll
                for (int bj = 0; bj < 2; ++bj)
#pragma unroll
                    for (int n = 0; n < 2; ++n) b[m][bj][n] = *(const f32x4*)(bp + off + bj * HALF + n * 16); }
#pragma unroll
            for (int m = 0; m < 4; ++m) { const size_t off = (size_t)(rowt + ai * HALF + m * 16) * D_MODEL + col0;
#pragma unroll
                for (int bj = 0; bj < 2; ++bj)
#pragma unroll
                    for (int n = 0; n < 2; ++n) *(f32x4*)(op + off + bj * HALF + n * 16) = b[m][bj][n] + gv[bj][n] * acc[ai][bj][m][n]; }
        }
    }
};

struct EpiQKV {
    static constexpr bool PERM = true, AFTER_DRAIN = false;
    bf16_t* O; int ldc; const float* qn; const float* kn; const float* cosT; const float* sinT;
    __device__ __forceinline__ void operator()(const f32x4 (&acc)[2][2][4][2], const Unit& u, int wr, int wc, int fr, int fq) const {
        const int hd = u.pn * 4 + wc;
        const bool lat = u.pm < (N_LAT / BM);
        const bool rope = lat && (hd < 10 || hd == 16 || hd == 17 || hd == 20 || hd == 21);
        const bool qnorm = (hd >= 6 && hd < 10), knorm = (hd == 20 || hd == 21);
        const float qs = hd < 16 ? 0.125f * 1.4426950408889634f : 1.0f;
        const int row0 = u.pm * BM + wr * 64 + fr, col0 = u.pn * BM + wc * 64 + 8 * fq;
        f32x4 gn[2][2];
        if (qnorm || knorm) { const float* gp = (qnorm ? qn : kn) + 8 * fq;
#pragma unroll
            for (int bj = 0; bj < 2; ++bj)
#pragma unroll
                for (int n = 0; n < 2; ++n) gn[bj][n] = *(const f32x4*)(gp + bj * 32 + n * 4); }
#pragma unroll
        for (int am = 0; am < 4; ++am) { const int ai = am >> 1;
            f32x4 cs[4][2], sn[4][2];
            if (rope) {
#pragma unroll
                for (int m = 2 * (am & 1); m < 2 * (am & 1) + 2; ++m) { const int t = (row0 + ai * HALF + m * 16) & 8191;
#pragma unroll
                    for (int n = 0; n < 2; ++n) { cs[m][n] = *(const f32x4*)(cosT + t * 32 + 8 * fq + 4 * n); sn[m][n] = *(const f32x4*)(sinT + t * 32 + 8 * fq + 4 * n); } }
            }
#pragma unroll
            for (int m = 2 * (am & 1); m < 2 * (am & 1) + 2; ++m) {
                const int row = row0 + ai * HALF + m * 16;
                f32x4 x[2][2];
#pragma unroll
                for (int bj = 0; bj < 2; ++bj)
#pragma unroll
                    for (int n = 0; n < 2; ++n) x[bj][n] = acc[ai][bj][m][n];
                if (qnorm || knorm) {
                    float ss = 0.f;
#pragma unroll
                    for (int bj = 0; bj < 2; ++bj)
#pragma unroll
                        for (int n = 0; n < 2; ++n) ss += (x[bj][n][0] * x[bj][n][0] + x[bj][n][1] * x[bj][n][1]) + (x[bj][n][2] * x[bj][n][2] + x[bj][n][3] * x[bj][n][3]);
                    ss += __shfl_xor(ss, 16); ss += __shfl_xor(ss, 32);
                    const float rs = __builtin_amdgcn_rsqf(ss * (1.0f / 64.0f) + 1e-6f);
#pragma unroll
                    for (int bj = 0; bj < 2; ++bj)
#pragma unroll
                        for (int n = 0; n < 2; ++n) x[bj][n] = x[bj][n] * rs * gn[bj][n];
                }
                if (rope) {
#pragma unroll
                    for (int n = 0; n < 2; ++n) { const f32x4 c = cs[m][n], s = sn[m][n];
                        const f32x4 a = x[0][n], b = x[1][n]; x[0][n] = a * c - b * s; x[1][n] = b * c + a * s; }
                }
                bf16_t* rowp = O + (size_t)row * ldc + col0;
#pragma unroll
                for (int bj = 0; bj < 2; ++bj) { const f32x4 v0 = x[bj][0] * qs, v1 = x[bj][1] * qs;
                    u32x4 w; w.x = cvt_pk_bf16(v0[0], v0[1]); w.y = cvt_pk_bf16(v0[2], v0[3]); w.z = cvt_pk_bf16(v1[0], v1[1]); w.w = cvt_pk_bf16(v1[2], v1[3]);
                    __builtin_nontemporal_store(w, (u32x4*)(rowp + bj * 32)); }
            }
        }
    }
};

template <class Epi, class Sched, bool ALIGN_EPI = false, bool SP2 = false>
__device__ __forceinline__ void gemm_phase(PG8_LAS unsigned char* lds, const Gemm g, const Sched& S, const Epi& E) {
    int tid = threadIdx.x; asm volatile("" : "+v"(tid)); const int wid = __builtin_amdgcn_readfirstlane(tid >> 6), lane = tid & 63, wr = wid >> 2, wc = wid & 3, fr = lane & 15, fq = lane >> 4;
    const int K = g.K;
    unsigned voffA[2], voffB[2];
#pragma unroll
    for (int i = 0; i < 2; ++i) { int R, C; stage_rc(tid * 16 + i * 8192, R, C); const int Rb = Epi::PERM ? ((R & ~31) + perm32(R & 31)) : R;
        voffA[i] = (unsigned)(R * BK + C) * 2u; voffB[i] = (unsigned)(Rb * BK + C) * 2u; }
    const size_t kstep = (size_t)(BM * BK * 2);
    const size_t hstep = (size_t)HALF * BK * 2;
    const size_t tstep = (size_t)BM * K * 2;
    const unsigned ldsw = (unsigned)wid * 1024u;
    const int aoff = lds_byte(wr * 64 + fr, fq * 8), boff = lds_byte(wc * 32 + fr, fq * 8);
#define PG8_SA(b, h) (((b) * 2 + (h)) * HTB)
#define PG8_SB(b, h) ((4 + (b) * 2 + (h)) * HTB)
#define PG8_STAGE(bufoff, gbase, voff) do { _Pragma("unroll") for (int _i = 0; _i < 2; ++_i) \
        __builtin_amdgcn_global_load_lds((const unsigned*)((const char*)(gbase) + (voff)[_i]), (PG8_LAS unsigned*)(lds + (bufoff) + ldsw + _i * 8192), 16, 0, 0); } while (0)
#define PG8_LDA(dst, b, h) do { _Pragma("unroll") for (int m = 0; m < 4; ++m) _Pragma("unroll") for (int k = 0; k < 2; ++k) dst[m][k] = *(const PG8_LAS bf16x8*)(lds + PG8_SA(b, h) + aoff + m * 2048 + k * 1024); } while (0)
#define PG8_LDB(dst, b, h) do { _Pragma("unroll") for (int n = 0; n < 2; ++n) _Pragma("unroll") for (int k = 0; k < 2; ++k) dst[n][k] = *(const PG8_LAS bf16x8*)(lds + PG8_SB(b, h) + boff + n * 2048 + k * 1024); } while (0)
#define PG8_MMA(ai, bj, At, Bt) do { __builtin_amdgcn_s_setprio(1); _Pragma("unroll") for (int m = 0; m < 4; ++m) _Pragma("unroll") for (int n = 0; n < 2; ++n) _Pragma("unroll") for (int k = 0; k < 2; ++k) \
        acc[ai][bj][m][n] = __builtin_amdgcn_mfma_f32_16x16x32_bf16(Bt[n][k], At[m][k], acc[ai][bj][m][n], 0, 0, 0); __builtin_amdgcn_s_setprio(0); } while (0)
#define PG8_WAIT_V(n) asm volatile("s_waitcnt vmcnt(" #n ")" ::: "memory")
#define PG8_WAIT_L(n) asm volatile("s_waitcnt lgkmcnt(" #n ")" ::: "memory")
#define PG8_BAR __builtin_amdgcn_s_barrier()
#define PG8_SCHED __builtin_amdgcn_sched_barrier(0)
    Unit cur, nxt; int ui = 0;
    if (!S.next(0, cur)) return;
    f32x4 acc[2][2][4][2];
#pragma unroll
    for (int a = 0; a < 2; ++a)
#pragma unroll
        for (int b = 0; b < 2; ++b)
#pragma unroll
            for (int m = 0; m < 4; ++m)
#pragma unroll
                for (int n = 0; n < 2; ++n) acc[a][b][m][n] = (f32x4){0.f, 0.f, 0.f, 0.f};
    bf16x8 At[4][2], B0[2][2], B1[2][2];
    const char* cA = (const char*)g.A + (size_t)cur.pm * tstep + (size_t)cur.k0t * kstep; const char* cB = (const char*)g.Bt + (size_t)cur.pn * tstep + (size_t)cur.k0t * kstep;
    S.a_ready(cur);
    if constexpr (SP2) {
        PG8_STAGE(PG8_SB(0, 0), cB, voffB); PG8_STAGE(PG8_SB(0, 1), cB + hstep, voffB); PG8_STAGE(PG8_SA(0, 0), cA, voffA); PG8_STAGE(PG8_SA(0, 1), cA + hstep, voffA);
        if (wr == 1) PG8_BAR;
        PG8_WAIT_V(2); PG8_BAR;
        PG8_STAGE(PG8_SB(1, 0), cB + kstep, voffB); PG8_STAGE(PG8_SA(1, 0), cA + kstep, voffA); PG8_STAGE(PG8_SB(1, 1), cB + hstep + kstep, voffB);
        PG8_WAIT_V(6); PG8_BAR;
    } else {
        PG8_STAGE(PG8_SB(0, 0), cB, voffB); PG8_STAGE(PG8_SA(0, 0), cA, voffA); PG8_STAGE(PG8_SB(0, 1), cB + hstep, voffB); PG8_STAGE(PG8_SA(0, 1), cA + hstep, voffA);
        if (wr == 1) PG8_BAR;
        PG8_WAIT_V(4); PG8_BAR;
        PG8_STAGE(PG8_SB(1, 0), cB + kstep, voffB); PG8_STAGE(PG8_SA(1, 0), cA + kstep, voffA); PG8_STAGE(PG8_SB(1, 1), cB + hstep + kstep, voffB);
        PG8_WAIT_V(6); PG8_BAR;
    }
    for (;;) {
        const bool has_next = S.next(ui + 1, nxt);
        const char* nA = has_next ? (const char*)g.A + (size_t)nxt.pm * tstep + (size_t)nxt.k0t * kstep : cA; const char* nB = has_next ? (const char*)g.Bt + (size_t)nxt.pn * tstep + (size_t)nxt.k0t * kstep : cB;
        const int nt = cur.nt;
        for (int t = 0; t < nt; t += 2) {
            const bool last = (t == nt - 2);
            const char* a1 = cA + (size_t)(t + 1) * kstep;
            const char* a2 = last ? nA : cA + (size_t)(t + 2) * kstep; const char* b2 = last ? nB : cB + (size_t)(t + 2) * kstep;
            const char* a3 = a2 + kstep; const char* b3 = b2 + kstep;
            if (last && has_next) S.a_ready(nxt);
            if constexpr (SP2) {
            PG8_LDB(B0, 0, 0); PG8_LDB(B1, 0, 1); PG8_SCHED; PG8_LDA(At, 0, 0); PG8_STAGE(PG8_SA(1, 1), a1 + hstep, voffA);
            PG8_WAIT_V(8); PG8_WAIT_L(0); PG8_BAR; PG8_MMA(0, 0, At, B0); PG8_MMA(0, 1, At, B1); PG8_BAR; PG8_SCHED;
            PG8_LDA(At, 0, 1); PG8_STAGE(PG8_SB(0, 0), b2, voffB); PG8_STAGE(PG8_SB(0, 1), b2 + hstep, voffB); PG8_STAGE(PG8_SA(0, 0), a2, voffA);
            PG8_WAIT_V(8); PG8_WAIT_L(0); PG8_BAR; PG8_MMA(1, 0, At, B0); PG8_MMA(1, 1, At, B1); PG8_BAR; PG8_SCHED;
            PG8_LDB(B0, 1, 0); PG8_LDB(B1, 1, 1); PG8_SCHED; PG8_LDA(At, 1, 0); PG8_STAGE(PG8_SA(0, 1), a2 + hstep, voffA);
            PG8_WAIT_V(8); PG8_WAIT_L(0); PG8_BAR; PG8_MMA(0, 0, At, B0); PG8_MMA(0, 1, At, B1); PG8_BAR; PG8_SCHED;
            PG8_LDA(At, 1, 1); PG8_STAGE(PG8_SB(1, 0), b3, voffB); PG8_STAGE(PG8_SB(1, 1), b3 + hstep, voffB); PG8_STAGE(PG8_SA(1, 0), a3, voffA);
            PG8_WAIT_V(8); PG8_WAIT_L(0); PG8_BAR; PG8_MMA(1, 0, At, B0); PG8_MMA(1, 1, At, B1); PG8_BAR; PG8_SCHED;
            } else {
            PG8_LDB(B0, 0, 0); PG8_SCHED; PG8_LDA(At, 0, 0); PG8_STAGE(PG8_SA(1, 1), a1 + hstep, voffA);
            PG8_WAIT_L(8); PG8_BAR; PG8_WAIT_L(0); PG8_MMA(0, 0, At, B0); PG8_BAR; PG8_SCHED;
            PG8_LDB(B1, 0, 1); PG8_STAGE(PG8_SB(0, 0), b2, voffB);
            PG8_BAR; PG8_WAIT_L(0); PG8_MMA(0, 1, At, B1); PG8_BAR;
            PG8_LDA(At, 0, 1); PG8_STAGE(PG8_SA(0, 0), a2, voffA);
            PG8_BAR; PG8_WAIT_L(0); PG8_MMA(1, 0, At, B0); PG8_BAR; PG8_SCHED;
            PG8_STAGE(PG8_SB(0, 1), b2 + hstep, voffB);
            PG8_WAIT_V(6); PG8_BAR; PG8_MMA(1, 1, At, B1); PG8_BAR;
            PG8_LDB(B0, 1, 0); PG8_SCHED; PG8_LDA(At, 1, 0); PG8_STAGE(PG8_SA(0, 1), a2 + hstep, voffA);
            PG8_WAIT_L(8); PG8_BAR; PG8_WAIT_L(0); PG8_MMA(0, 0, At, B0); PG8_BAR; PG8_SCHED;
            PG8_LDB(B1, 1, 1); PG8_STAGE(PG8_SB(1, 0), b3, voffB);
            PG8_BAR; PG8_WAIT_L(0); PG8_MMA(0, 1, At, B1); PG8_BAR;
            PG8_LDA(At, 1, 1); PG8_STAGE(PG8_SA(1, 0), a3, voffA);
            PG8_BAR; PG8_WAIT_L(0); PG8_MMA(1, 0, At, B0); PG8_BAR; PG8_SCHED;
            PG8_STAGE(PG8_SB(1, 1), b3 + hstep, voffB);
            PG8_WAIT_V(6); PG8_BAR; PG8_MMA(1, 1, At, B1); PG8_BAR;
            }
        }
        if constexpr (ALIGN_EPI) { if (wr == 0) PG8_BAR; }
        if constexpr (!Epi::AFTER_DRAIN) { E(acc, cur, wr, wc, fr, fq); S.done(cur); }
        if (!has_next) break;
#pragma unroll
        for (int a = 0; a < 2; ++a)
#pragma unroll
            for (int b = 0; b < 2; ++b)
#pragma unroll
                for (int m = 0; m < 4; ++m)
#pragma unroll
                    for (int n = 0; n < 2; ++n) acc[a][b][m][n] = (f32x4){0.f, 0.f, 0.f, 0.f};
        cur = nxt; cA = nA; cB = nB; ++ui;
        if constexpr (ALIGN_EPI) { if (wr == 1) PG8_BAR; }
    }
    PG8_WAIT_V(0);
    if constexpr (!ALIGN_EPI) { if (wr == 0) PG8_BAR; }
    PG8_BAR;
    if constexpr (Epi::AFTER_DRAIN) { E.fused(acc, cur, wr, wc, fr, fq, lds, wid, lane); S.done(cur); }
#undef PG8_SA
#undef PG8_SB
#undef PG8_STAGE
#undef PG8_LDA
#undef PG8_LDB
#undef PG8_MMA
#undef PG8_WAIT_V
#undef PG8_WAIT_L
#undef PG8_BAR
#undef PG8_SCHED
}
}
namespace att {
#define ATT_LAS __attribute__((address_space(3)))
typedef unsigned short bf16_t;
typedef short bf16x8 __attribute__((ext_vector_type(8)));
typedef short s16x4 __attribute__((ext_vector_type(4)));
typedef float f32x16 __attribute__((ext_vector_type(16)));
typedef unsigned u32x4 __attribute__((ext_vector_type(4)));
typedef unsigned u32x2 __attribute__((ext_vector_type(2)));
constexpr int PITCH = 2304, YPITCH = 1024, NLAT = 32768;
constexpr float LOG2E = 1.4426950408889634f, NEGF = -1e30f;
constexpr int LDS_K = 0, LDS_V = 24576, LDS_TBL = 40960 + 256;
struct AUnit { int mode, qrow0, qpos0, qcol, kcol, vcol, crow0, lrow0, t_lo, t_hi, hb; float sink; };

__device__ __forceinline__ int clampi(int v, int lo, int hi) { return v < lo ? lo : (v > hi ? hi : v); }
__device__ __forceinline__ void decode(int v, const float* sink_l, AUnit& a) {
    a.sink = NEGF; a.hb = 0;
    if (v < 512) { const int xcd = v & 7, slot = (v >> 3) & 31, i = v >> 8, b = xcd >> 1, kvh = xcd & 1, hq = 2 * kvh + i;
        a.mode = 0; a.qrow0 = b * 8192 + slot * 256; a.qpos0 = slot * 256; a.qcol = 384 + 64 * hq; a.kcol = 1280 + 64 * kvh; a.vcol = 1408 + 64 * kvh;
        a.crow0 = NLAT + b * 256; a.lrow0 = b * 8192; a.t_lo = 0; a.t_hi = 128; return; }
    if (v < 1280) { const int w = v - 512, b = w / 192, r = w % 192, hq = r >> 5, qb = r & 31, kvh = hq / 3;
        a.mode = 1; a.qrow0 = b * 8192 + qb * 256; a.qpos0 = qb * 256; a.qcol = 64 * hq; a.kcol = 1024 + 64 * kvh; a.vcol = 1152 + 64 * kvh;
        a.crow0 = NLAT + b * 256; a.lrow0 = b * 8192; a.t_lo = (4 * qb - 2) < 0 ? 0 : (4 * qb - 2); a.t_hi = (4 * qb + 6) > 128 ? 128 : (4 * qb + 6);
        a.sink = sink_l[hq] * LOG2E; return; }
    if (v < 2048) { const int w = v - 1280, b = w / 192, r = w % 192, h = r >> 5, qb = r & 31, r0 = 4 * qb;
        a.mode = 2; a.qrow0 = b * 8192 + qb * 256; a.qpos0 = qb * 256; a.qcol = 640 + 64 * h; a.kcol = 1536 + 64 * h; a.vcol = 1920 + 64 * h;
        a.crow0 = NLAT + b * 256; a.lrow0 = b * 8192; a.t_lo = clampi(r0 - 4, 0, 120); a.t_hi = clampi(r0 - 1, 0, 120) + 8; a.hb = h; return; }
    { const int w = v - 2048, b = w >> 4, hh = w & 15;
        a.mode = 0; a.qrow0 = NLAT + b * 256; a.qpos0 = 0; a.qcol = 64 * hh; a.crow0 = NLAT + b * 256; a.lrow0 = 0; a.t_lo = 0; a.t_hi = 0;
        if (hh < 6) { const int kvh = hh / 3; a.kcol = 1024 + 64 * kvh; a.vcol = 1152 + 64 * kvh; a.sink = sink_l[hh] * LOG2E; }
        else if (hh < 10) { const int kvh = (hh - 6) >> 1; a.kcol = 1280 + 64 * kvh; a.vcol = 1408 + 64 * kvh; }
        else { const int h = hh - 10; a.kcol = 1536 + 64 * h; a.vcol = 1920 + 64 * h; } }
}
__device__ __forceinline__ unsigned pk_bf16(float lo, float hi) { unsigned r; asm volatile("v_cvt_pk_bf16_f32 %0, %1, %2" : "=v"(r) : "v"(lo), "v"(hi)); return r; }
__device__ __forceinline__ s16x4 vtr(const ATT_LAS unsigned char* p) { typedef short v4i16_t __attribute__((ext_vector_type(4)));
    return __builtin_bit_cast(s16x4, __builtin_amdgcn_ds_read_tr16_b64_v4i16((ATT_LAS v4i16_t*)p)); }
__device__ __forceinline__ int crow(int r, int hi) { return (r & 3) + 8 * (r >> 2) + 4 * hi; }

#define ATT_SB() __builtin_amdgcn_sched_barrier(0)
__device__ __forceinline__ float max3f(float x, float y, float z) { return __builtin_fmaxf(__builtin_fmaxf(x, y), z); }
__device__ __forceinline__ float rowmax32(const f32x16& p0, const f32x16& p1) {
    float x = max3f(p0[0], p0[1], p1[0]), y = max3f(p0[2], p0[3], p1[1]); x = max3f(x, p1[2], p1[3]);
#pragma unroll
    for (int r = 4; r < 16; r += 4) { x = max3f(x, p0[r], p0[r + 1]); y = max3f(y, p0[r + 2], p0[r + 3]); x = max3f(x, p1[r], p1[r + 1]); y = max3f(y, p1[r + 2], p1[r + 3]); }
    const float mm = __builtin_fmaxf(x, y);
    auto rr = __builtin_amdgcn_permlane32_swap(__float_as_uint(mm), __float_as_uint(mm), false, false);
    return __builtin_fmaxf(__uint_as_float(rr[0]), __uint_as_float(rr[1]));
}
__device__ __forceinline__ float halfsum(float v) { auto rr = __builtin_amdgcn_permlane32_swap(__float_as_uint(v), __float_as_uint(v), false, false); return __uint_as_float(rr[0]) + __uint_as_float(rr[1]); }

#define ATT_TROW(t) ((t) < 4 ? a.crow0 + 64 * (t) : a.lrow0 + 64 * (a.t_lo + (t) - 4))
#define ATT_KBUF(i) (lds + LDS_K + (i) * 8192)
#define ATT_VBUF(i) (lds + LDS_V + (i) * 8192)
#define ATT_LDK(dst, buf) do { _Pragma("unroll") for (int d0_ = 0; d0_ < 4; ++d0_) { dst[2 * d0_] = *(const ATT_LAS bf16x8*)((buf) + kfrag + d0_ * 2048); dst[2 * d0_ + 1] = *(const ATT_LAS bf16x8*)((buf) + kfrag + d0_ * 2048 + 512); } } while (0)
template <bool NOMAX>
__device__ __forceinline__ void pipe_tiles(const AUnit& a, const int NF, const bf16_t* kg, const bf16_t* vg, const bf16x8 (&qf)[4], ATT_LAS unsigned char* lds,
                                           const int koff, const int voff, const int kfrag, const int vlane, float& m, float& lsum, f32x16& o0, f32x16& o1) {
        const f32x16 zero16 = {};
        u32x4 kreg, vreg; bf16x8 kf[8]; f32x16 c0, c1, e0, e1;
        { const u32x4 k0 = *(const u32x4*)(kg + (size_t)ATT_TROW(0) * PITCH), k1 = *(const u32x4*)(kg + (size_t)ATT_TROW(1) * PITCH);
          *(ATT_LAS u32x4*)(ATT_KBUF(0) + koff) = k0; *(ATT_LAS u32x4*)(ATT_KBUF(1) + koff) = k1; }
        __syncthreads();
        kreg = *(const u32x4*)(kg + (size_t)ATT_TROW(2) * PITCH); vreg = *(const u32x4*)(vg + (size_t)ATT_TROW(0) * PITCH);
        ATT_LDK(kf, ATT_KBUF(0));
        c0 = (f32x16){}; c1 = (f32x16){};
#pragma unroll
        for (int d0 = 0; d0 < 4; ++d0) { c0 = __builtin_amdgcn_mfma_f32_32x32x16_bf16(kf[2 * d0], qf[d0], c0, 0, 0, 0); c1 = __builtin_amdgcn_mfma_f32_32x32x16_bf16(kf[2 * d0 + 1], qf[d0], c1, 0, 0, 0); }
        m = NOMAX ? 0.f : rowmax32(c0, c1);
#pragma unroll
        for (int r = 0; r < 16; ++r) { e0[r] = __builtin_amdgcn_exp2f(c0[r] - m); e1[r] = __builtin_amdgcn_exp2f(c1[r] - m); }
        ATT_LDK(kf, ATT_KBUF(1));
        *(ATT_LAS u32x4*)(ATT_KBUF(2) + koff) = kreg; *(ATT_LAS u32x4*)(ATT_VBUF(0) + voff) = vreg;
        __syncthreads();
        u32x4 kregB = kreg, vregB = vreg;
        kreg = *(const u32x4*)(kg + (size_t)ATT_TROW(3) * PITCH); vreg = *(const u32x4*)(vg + (size_t)ATT_TROW(1) * PITCH);
        int kb2 = 0;
#define ATT_PIN(x) asm volatile("" : "+v"(x))
#define ATT_STEP(t, KW, VW, KL, VL, E0, E1, C0, C1) do { \
            const bool ldk = ((t) + 2 < NF); \
              \
            if (ldk) *(ATT_LAS u32x4*)(ATT_KBUF(kb2) + koff) = KW; \
            *(ATT_LAS u32x4*)(ATT_VBUF((t) & 1) + voff) = VW; \
            if ((t) + 3 < NF) KL = *(const u32x4*)(kg + (size_t)ATT_TROW((t) + 3) * PITCH); \
            if ((t) + 1 < NF) VL = *(const u32x4*)(vg + (size_t)ATT_TROW((t) + 1) * PITCH); \
            const ATT_LAS unsigned char* vb = ATT_VBUF(((t) - 1) & 1) + vlane; \
            s16x4 vlo[4], vh4[4], wlo[4], wh4[4]; \
            _Pragma("unroll") for (int i = 0; i < 4; ++i) { vlo[i] = vtr(vb + i * 1024); vh4[i] = vtr(vb + i * 1024 + 512); } \
            ATT_SB(); \
            u32x4 pw[4]; float sacc = 0.f; \
            _Pragma("unroll") for (int i = 0; i < 8; ++i) { \
                const int d0 = i >> 1; \
                if (i & 1) C1 = __builtin_amdgcn_mfma_f32_32x32x16_bf16(kf[i], qf[d0], d0 == 0 ? zero16 : C1, 0, 0, 0); \
                else       C0 = __builtin_amdgcn_mfma_f32_32x32x16_bf16(kf[i], qf[d0], d0 == 0 ? zero16 : C0, 0, 0, 0); \
                _Pragma("unroll") for (int j = 0; j < 4; ++j) { const int f = 4 * i + j; sacc += (f < 16 ? E0[f & 15] : E1[f & 15]); } \
                ATT_PIN(sacc); \
                _Pragma("unroll") for (int j = 0; j < 2; ++j) { const int f = 4 * i + 2 * j; const float x0 = (f < 16 ? E0[f & 15] : E1[f & 15]), x1 = (f < 16 ? E0[(f + 1) & 15] : E1[(f + 1) & 15]); \
                    pw[(2 * i + j) >> 2][(2 * i + j) & 3] = pk_bf16(x0, x1); } \
                ATT_SB(); \
            } \
            lsum += sacc; \
            float fsc = 1.0f; bool resc = false; \
            if (!NOMAX) { const float rm = rowmax32(C0, C1) - m; resc = __any(rm > 8.0f); \
            if (resc) { const float dl = __builtin_fmaxf(rm, 0.f); m += dl; fsc = __builtin_amdgcn_exp2f(-dl); lsum *= fsc; } \
                _Pragma("unroll") for (int r = 0; r < 16; ++r) { C0[r] -= m; C1[r] -= m; } } \
            ATT_SB(); \
            _Pragma("unroll") for (int i = 0; i < 4; ++i) { wlo[i] = vtr(vb + 4096 + i * 1024); wh4[i] = vtr(vb + 4096 + i * 1024 + 512); }     \
            ATT_SB(); \
            _Pragma("unroll") for (int i = 0; i < 8; ++i) { \
                const int s = i & 3; const bf16x8 pa = __builtin_bit_cast(bf16x8, pw[s]); \
                if (i < 4) { const bf16x8 vf = (bf16x8){vlo[s][0], vlo[s][1], vlo[s][2], vlo[s][3], vh4[s][0], vh4[s][1], vh4[s][2], vh4[s][3]}; \
                    o0 = __builtin_amdgcn_mfma_f32_32x32x16_bf16(vf, pa, o0, 0, 0, 0); } \
                else { const bf16x8 vf = (bf16x8){wlo[s][0], wlo[s][1], wlo[s][2], wlo[s][3], wh4[s][0], wh4[s][1], wh4[s][2], wh4[s][3]}; \
                    o1 = __builtin_amdgcn_mfma_f32_32x32x16_bf16(vf, pa, o1, 0, 0, 0); } \
                if (i < 4) { _Pragma("unroll") for (int j = 0; j < 4; ++j) C0[4 * i + j] = __builtin_amdgcn_exp2f(C0[4 * i + j]); ATT_PIN(C0); } \
                else       { _Pragma("unroll") for (int j = 0; j < 4; ++j) C1[4 * i - 16 + j] = __builtin_amdgcn_exp2f(C1[4 * i - 16 + j]); ATT_PIN(C1); } \
                if (i >= 2 && i < 6) { const int d0 = i - 2; const ATT_LAS unsigned char* kb = ATT_KBUF(kb2 == 0 ? 2 : kb2 - 1); \
                    kf[2 * d0] = *(const ATT_LAS bf16x8*)(kb + kfrag + d0 * 2048); kf[2 * d0 + 1] = *(const ATT_LAS bf16x8*)(kb + kfrag + d0 * 2048 + 512); } \
                ATT_SB(); \
            } \
            if (!NOMAX && resc) { \
                _Pragma("unroll") for (int r = 0; r < 16; ++r) { o0[r] *= fsc; o1[r] *= fsc; } } \
            kb2 = (kb2 == 2) ? 0 : kb2 + 1; \
            __syncthreads(); \
        } while (0)
        for (int t = 1; t < NF; t += 2) {
            ATT_STEP(t, kreg, vreg, kregB, vregB, e0, e1, c0, c1);
            if (t + 1 < NF) ATT_STEP(t + 1, kregB, vregB, kreg, vreg, c0, c1, e0, e1);
        }
        if ((NF - 1) & 1) { e0 = c0; e1 = c1; }
#undef ATT_STEP
#undef ATT_PIN
        { u32x4 pw[4]; float sacc = 0.f;
#pragma unroll
          for (int r = 0; r < 16; ++r) sacc += e0[r] + e1[r];
          lsum += sacc;
#pragma unroll
          for (int j = 0; j < 4; ++j) { pw[0][j] = pk_bf16(e0[2 * j], e0[2 * j + 1]); pw[1][j] = pk_bf16(e0[8 + 2 * j], e0[8 + 2 * j + 1]);
                                        pw[2][j] = pk_bf16(e1[2 * j], e1[2 * j + 1]); pw[3][j] = pk_bf16(e1[8 + 2 * j], e1[8 + 2 * j + 1]); }
          const ATT_LAS unsigned char* vb = ATT_VBUF((NF - 1) & 1) + vlane;
#pragma unroll
          for (int s = 0; s < 4; ++s) { const bf16x8 pa = __builtin_bit_cast(bf16x8, pw[s]);
              { const s16x4 lo = vtr(vb + s * 1024), h4 = vtr(vb + s * 1024 + 512); const bf16x8 vf = (bf16x8){lo[0], lo[1], lo[2], lo[3], h4[0], h4[1], h4[2], h4[3]};
                o0 = __builtin_amdgcn_mfma_f32_32x32x16_bf16(vf, pa, o0, 0, 0, 0); }
              { const s16x4 lo = vtr(vb + 4096 + s * 1024), h4 = vtr(vb + 4096 + s * 1024 + 512); const bf16x8 vf = (bf16x8){lo[0], lo[1], lo[2], lo[3], h4[0], h4[1], h4[2], h4[3]};
                o1 = __builtin_amdgcn_mfma_f32_32x32x16_bf16(vf, pa, o1, 0, 0, 0); } }
        }
        __syncthreads();
}

__device__ __forceinline__ void attn_unit(int uv, const float* sink_l, const bf16_t* P, bf16_t* Y, ATT_LAS unsigned char* lds, const float* rpb_l, const float* qn_l, const float* kn_l) {
    AUnit a; decode(uv, sink_l, a);
    int tid = threadIdx.x; asm volatile("" : "+v"(tid)); const int lane = tid & 63, r32 = lane & 31, hi = lane >> 5; const int wid = __builtin_amdgcn_readfirstlane(tid >> 6);
    const int kkey = 8 * wid + (lane & 7), kc = lane >> 3;
    const int vkey = 8 * wid + ((lane >> 2) & 1) + 2 * ((lane >> 4) & 3), vd8 = (lane & 3) + 4 * ((lane >> 3) & 1);
    const int koff = (kc >> 1) * 2048 + (kc & 1) * 1024 + (kkey >> 5) * 512 + (kkey & 31) * 16;
    const int voff = (vd8 >> 2) * 4096 + (vkey >> 3) * 512 + (vkey & 7) * 64 + (vd8 & 3) * 16;
    const bf16_t* kg = P + (size_t)kkey * PITCH + a.kcol + kc * 8;
    const bf16_t* vg = P + (size_t)vkey * PITCH + a.vcol + vd8 * 8;
    ATT_LAS float* tbl = (ATT_LAS float*)(lds + LDS_TBL);
    if (a.mode == 2) { for (int i = tid; i < 465; i += 512) tbl[i] = rpb_l[a.hb * 465 + i] * LOG2E; }
    const int qrow = a.qrow0 + 32 * wid + r32;
    bf16x8 qf[4];
#pragma unroll
    for (int d0 = 0; d0 < 4; ++d0) qf[d0] = *(const bf16x8*)(P + (size_t)qrow * PITCH + a.qcol + 16 * d0 + 8 * hi);
    const int nlat = a.t_hi - a.t_lo;
    const int kfrag = hi * 1024 + r32 * 16;
    const int vlane = ((lane >> 4) & 1) * 32 + (lane & 3) * 8 + (4 * hi + ((lane & 15) >> 2)) * 64;
    float m, lsum = 0.f; f32x16 o0 = {}, o1 = {};
    {
        const int NF = 4 + (a.mode == 0 ? nlat : 0);
        bool nomax = false;
        if (uv < 512) {
            float gq = __builtin_fabsf(qn_l[lane]), gk = __builtin_fabsf(kn_l[lane]);
#pragma unroll
            for (int o = 1; o < 64; o <<= 1) { gq = __builtin_fmaxf(gq, __shfl_xor(gq, o)); gk = __builtin_fmaxf(gk, __shfl_xor(gk, o)); }
            nomax = __builtin_amdgcn_readfirstlane(__float_as_int(gq * gk * (8.0f * LOG2E))) < __float_as_int(40.0f);
        }
        if (nomax) pipe_tiles<true>(a, NF, kg, vg, qf, lds, koff, voff, kfrag, vlane, m, lsum, o0, o1);
        else       pipe_tiles<false>(a, NF, kg, vg, qf, lds, koff, voff, kfrag, vlane, m, lsum, o0, o1);
    }
    if (a.mode != 0 && nlat > 0) {
        u32x4 kreg, vreg;
        { const size_t ro = (size_t)ATT_TROW(4) * PITCH; kreg = *(const u32x4*)(kg + ro); vreg = *(const u32x4*)(vg + ro); }
        *(ATT_LAS u32x4*)(ATT_KBUF(0) + koff) = kreg; *(ATT_LAS u32x4*)(ATT_VBUF(0) + voff) = vreg;
        __syncthreads();
        const int qw = a.qpos0 + 32 * wid, qr = qw >> 6;
        for (int t = 0; t < nlat; ++t) {
            const int cur = t & 1, tl = a.t_lo + t;
            if (t + 1 < nlat) { const size_t ro = (size_t)ATT_TROW(t + 5) * PITCH; kreg = *(const u32x4*)(kg + ro); vreg = *(const u32x4*)(vg + ro); }
            bool need;
            if (a.mode == 1) need = (tl * 64 + 63 >= qw - 128) && (tl * 64 <= qw + 31 + 128);
            else { const int rs = clampi(qr - 4, 0, 120); need = (tl >= rs) && (tl < rs + 8); }
            if (need) {
                const ATT_LAS unsigned char* Kb = ATT_KBUF(cur); const ATT_LAS unsigned char* Vb = ATT_VBUF(cur);
                f32x16 p0 = {}, p1 = {};
#pragma unroll
                for (int d0 = 0; d0 < 4; ++d0) {
                    const bf16x8 k0 = *(const ATT_LAS bf16x8*)(Kb + kfrag + d0 * 2048);
                    const bf16x8 k1 = *(const ATT_LAS bf16x8*)(Kb + kfrag + d0 * 2048 + 512);
                    p0 = __builtin_amdgcn_mfma_f32_32x32x16_bf16(k0, qf[d0], p0, 0, 0, 0);
                    p1 = __builtin_amdgcn_mfma_f32_32x32x16_bf16(k1, qf[d0], p1, 0, 0, 0);
                }
                if (a.mode == 1) { const int dq = tl * 64 - (qw + r32);
#pragma unroll
                    for (int r = 0; r < 16; ++r) { const int d = dq + crow(r, hi); if (d > 128 || d < -128) p0[r] = NEGF; if (d + 32 > 128 || d + 32 < -128) p1[r] = NEGF; } }
                else { const int qc = 32 * (wid & 1) + r32, cs = clampi(qc - 8, 0, 48); const ATT_LAS float* trow = tbl + (tl - qr + 7) * 31 + 15 - qc;
#pragma unroll
                    for (int r = 0; r < 16; ++r) { const int kcl = crow(r, hi);
                        const float b0 = trow[kcl], b1 = trow[kcl + 32];
                        p0[r] = ((unsigned)(kcl - cs) < 16u) ? p0[r] + b0 : NEGF;
                        p1[r] = ((unsigned)(kcl + 32 - cs) < 16u) ? p1[r] + b1 : NEGF; } }
                const float mt = rowmax32(p0, p1);
                if (__any(mt > m)) { const float mn = fmaxf(m, mt), alpha = __builtin_amdgcn_exp2f(m - mn); m = mn; lsum *= alpha;
#pragma unroll
                    for (int r = 0; r < 16; ++r) { o0[r] *= alpha; o1[r] *= alpha; } }
                float sum = 0.f;
#pragma unroll
                for (int r = 0; r < 16; ++r) { p0[r] = __builtin_amdgcn_exp2f(p0[r] - m); p1[r] = __builtin_amdgcn_exp2f(p1[r] - m); sum += p0[r] + p1[r]; }
                lsum += sum;
                u32x4 pw[4];
#pragma unroll
                for (int j = 0; j < 4; ++j) { pw[0][j] = pk_bf16(p0[2 * j], p0[2 * j + 1]); pw[1][j] = pk_bf16(p0[8 + 2 * j], p0[8 + 2 * j + 1]);
                                              pw[2][j] = pk_bf16(p1[2 * j], p1[2 * j + 1]); pw[3][j] = pk_bf16(p1[8 + 2 * j], p1[8 + 2 * j + 1]); }
                const ATT_LAS unsigned char* vb = Vb + vlane;
#pragma unroll
                for (int s = 0; s < 4; ++s) {
                    const bf16x8 pa = __builtin_bit_cast(bf16x8, pw[s]);
                    { const s16x4 lo = vtr(vb + s * 1024), h4 = vtr(vb + s * 1024 + 512);
                      const bf16x8 vf = (bf16x8){lo[0], lo[1], lo[2], lo[3], h4[0], h4[1], h4[2], h4[3]};
                      o0 = __builtin_amdgcn_mfma_f32_32x32x16_bf16(vf, pa, o0, 0, 0, 0); }
                    { const s16x4 lo = vtr(vb + 4096 + s * 1024), h4 = vtr(vb + 4096 + s * 1024 + 512);
                      const bf16x8 vf = (bf16x8){lo[0], lo[1], lo[2], lo[3], h4[0], h4[1], h4[2], h4[3]};
                      o1 = __builtin_amdgcn_mfma_f32_32x32x16_bf16(vf, pa, o1, 0, 0, 0); }
                }
            }
            if (t + 1 < nlat) { *(ATT_LAS u32x4*)(ATT_KBUF(cur ^ 1) + koff) = kreg; *(ATT_LAS u32x4*)(ATT_VBUF(cur ^ 1) + voff) = vreg; }
            __syncthreads();
        }
    }
#undef ATT_TROW
#undef ATT_KBUF
#undef ATT_VBUF
#undef ATT_LDK
    lsum = halfsum(lsum);
    lsum += __builtin_amdgcn_exp2f(a.sink - m);
    const float inv = 1.0f / lsum;
    bf16_t* yr = Y + ((size_t)(qrow >> 8) * 16 + (a.qcol >> 6)) * 16384 + (qrow & 255) * 64 + 4 * hi;
#pragma unroll
    for (int g = 0; g < 4; ++g) {
        u32x2 w0, w1;
        w0.x = pk_bf16(o0[4 * g] * inv, o0[4 * g + 1] * inv); w0.y = pk_bf16(o0[4 * g + 2] * inv, o0[4 * g + 3] * inv);
        w1.x = pk_bf16(o1[4 * g] * inv, o1[4 * g + 1] * inv); w1.y = pk_bf16(o1[4 * g + 2] * inv, o1[4 * g + 3] * inv);
        *(u32x2*)(yr + 8 * g) = w0; *(u32x2*)(yr + 32 + 8 * g) = w1;
    }
}
}
#define LAS __attribute__((address_space(3)))
typedef unsigned short bf16;
typedef float f32x4 __attribute__((ext_vector_type(4)));
typedef unsigned v4u __attribute__((ext_vector_type(4)));
typedef unsigned v2u __attribute__((ext_vector_type(2)));
#ifndef NORM_REP
#define NORM_REP 1
#endif
#ifndef PRO_REP
#define PRO_REP 1
#endif
#ifndef SYNC_REP
#define SYNC_REP 1
#endif
#define GSYNC() do { unsigned oq_; asm volatile("s_mov_b32 %0, 0" : "=s"(oq_)); XcdBarrier xb_; xb_.bar = (unsigned*)(GASQ unsigned*)ldp_raw(lds0 + oq_, 23); xb_.x = xb_xcc_id(); xb_.st = (volatile LAS unsigned*)(lds0 + oq_ + MISC_OFF); for (int r_ = 0; r_ < SYNC_REP; ++r_) xcd_barrier(xb_); } while (0)
#ifndef G2_PMMASK
#define G2_PMMASK 0x7fffffff
#endif
#ifndef G2_REP
#define G2_REP 1
#endif
#ifndef G3_REP
#define G3_REP 1
#endif
#ifndef G1_REP
#define G1_REP 1
#endif
#ifndef ATT_EXTRA
#define ATT_EXTRA 0
#endif
#ifndef ATT_REP_N
#define ATT_REP_N 512
#endif
#ifndef PM
#define PM 127
#endif
constexpr int NWAVES = 8, NTHREADS = 512;
constexpr int D = 1024, FF = 2816, NLAT = 32768, NCTX = 1024, MFULL = NLAT + NCTX, WIN = 2304, MODROW = 9216, DEPTH = 2;
constexpr float EPS = 1e-6f;
constexpr size_t MiB = 1u << 20;
constexpr size_t WS_MOD = 1 * MiB, WS_COS = 2 * MiB, WS_SIN = 3 * MiB, WS_HC = 4 * MiB, WS_W = 8 * MiB;
constexpr size_t WL_GU1 = 0, WL_D1 = 11 * MiB, WL_IN = 16 * MiB + MiB / 2, WL_OUT = 21 * MiB, WL_GU2 = 23 * MiB, WL_D2 = 34 * MiB, WL_SIZE = 39 * MiB + MiB / 2;
constexpr size_t WS_U = 88 * MiB, WS_HID = 154 * MiB, WS_PART = 336 * MiB, WS_DUMMY = 352 * MiB, WS_END = 352 * MiB;
static_assert(WS_W + 2 * WL_SIZE <= WS_U && WS_U + (size_t)MFULL * D * 2 <= WS_HID && WS_HID + (size_t)MFULL * FF * 2 <= WS_PART, "ws map");
constexpr int LDS_BYTES = 147456;

__device__ __forceinline__ unsigned f2bf(float f) { unsigned u = __builtin_bit_cast(unsigned, f); return (u + 0x7fffu + ((u >> 16) & 1u)) >> 16; }
__device__ __forceinline__ unsigned pk2(float lo, float hi) { return f2bf(lo) | (f2bf(hi) << 16); }
__device__ __forceinline__ float wave_sum(float v) {
#pragma unroll
    for (int o = 1; o < 64; o <<= 1) v += __shfl_xor(v, o);
    return v;
}
__device__ __forceinline__ void transpose_item(const float* W, int K, int N, bf16* WT, int dst_row0, int k0, int n0, LAS float* scr, int lane) {
    f32x4 wv[8];
#pragma unroll
    for (int i = 0; i < 8; ++i) wv[i] = *(const f32x4*)(W + (size_t)(k0 + 8 * i + (lane >> 3)) * N + n0 + 4 * (lane & 7));
#pragma unroll
    for (int i = 0; i < 8; ++i) { LAS float* d = scr + (8 * i + (lane >> 3)) * 33 + 4 * (lane & 7); d[0] = wv[i][0]; d[1] = wv[i][1]; d[2] = wv[i][2]; d[3] = wv[i][3]; }
    asm volatile("s_waitcnt lgkmcnt(0)" ::: "memory");
    const int c = lane & 7;
#pragma unroll
    for (int j = 0; j < 4; ++j) { const int n = (lane >> 3) + 8 * j; const LAS float* s = scr + (8 * c) * 33 + n;
        v4u o; o.x = pk2(s[0 * 33], s[1 * 33]); o.y = pk2(s[2 * 33], s[3 * 33]); o.z = pk2(s[4 * 33], s[5 * 33]); o.w = pk2(s[6 * 33], s[7 * 33]);
        const int rr = dst_row0 + n; *(v4u*)(WT + ((size_t)(rr >> 8) * (K >> 6) + (k0 >> 6)) * 16384 + (rr & 255) * 64 + 8 * c) = o; }
    asm volatile("s_waitcnt lgkmcnt(0)" ::: "memory");
}

#define XB_TMO      128
#define XB_XCNT(j)  (256  + 64 * (j))
#define XB_XSUB(j)  (1280 + 64 * (j))
#define XB_XGEN(j)  (2304 + 64 * (j))
#define XB_TOP      3328
#define XB_TOPGEN   3392
#define XCD_BAR_WORDS 3456
#define XB_SPIN_CAP (1u << 18)

__device__ __forceinline__ unsigned xb_ld(unsigned* p)              { return __hip_atomic_load(p, __ATOMIC_RELAXED, __HIP_MEMORY_SCOPE_AGENT); }
__device__ __forceinline__ unsigned xb_add(unsigned* p, unsigned v) { return __hip_atomic_fetch_add(p, v, __ATOMIC_RELAXED, __HIP_MEMORY_SCOPE_AGENT); }
__device__ __forceinline__ unsigned xb_xcc_id() { return (unsigned)__builtin_amdgcn_s_getreg((3 << 11) | 20) & 0xFu; }
#define XB_SPIN(cond, bar) do { unsigned _sp = 0; while (cond) { __builtin_amdgcn_s_sleep(1); \
    if ((++_sp & 255u) == 0u) { if (xb_ld(&(bar)[XB_TMO])) break; if (_sp > XB_SPIN_CAP) { atomicAdd(&(bar)[XB_TMO], 1u); break; } } } } while (0)

struct XcdBarrier {
    unsigned* bar; unsigned x;
    volatile LAS unsigned* st;
};

__device__ __forceinline__ XcdBarrier xcd_barrier_post(unsigned* bar, volatile LAS unsigned* st) {
    XcdBarrier b; b.bar = bar; b.x = xb_xcc_id(); b.st = st;
    if (threadIdx.x == 0) (void)xb_add(&bar[XB_XCNT(b.x)], 1u);
    return b;
}
__device__ __forceinline__ void xcd_barrier_complete(unsigned* bar, unsigned x, unsigned& nloc, unsigned& nx) {
    const unsigned G = gridDim.x * gridDim.y * gridDim.z;
    unsigned sum, cnt, mine, sp = 0u;
    for (;;) {
        sum = 0u; cnt = 0u; mine = 0u;
#pragma unroll
        for (unsigned j = 0; j < 16; ++j) { const unsigned c = xb_ld(&bar[XB_XCNT(j)]); sum += c; cnt += (c > 0u) ? 1u : 0u; mine = (j == x) ? c : mine; }
        if (sum == G) break;
        __builtin_amdgcn_s_sleep(1);
        if ((++sp & 255u) == 0u) { if (xb_ld(&bar[XB_TMO])) break; if (sp > XB_SPIN_CAP) { atomicAdd(&bar[XB_TMO], 1u); break; } }
    }
    nloc = mine > 0u ? mine : 1u; nx = cnt > 0u ? cnt : 1u;
}

__device__ __forceinline__ void xcd_barrier(const XcdBarrier& b) {
    asm volatile("s_waitcnt vmcnt(0)" ::: "memory");
    __syncthreads();
    if (threadIdx.x == 0) {
        unsigned* bar = b.bar;
        __builtin_amdgcn_s_waitcnt(0);
        unsigned nloc = b.st[0], nx = b.st[1];
        if (nloc == 0u) { xcd_barrier_complete(bar, b.x, nloc, nx); b.st[0] = nloc; b.st[1] = nx; }
        const unsigned old = xb_add(&bar[XB_XSUB(b.x)], 1u);
        const unsigned gen = old / nloc;
        if (old + 1u == (gen + 1u) * nloc) {
            __builtin_amdgcn_fence(__ATOMIC_RELEASE, "agent");
            asm volatile("s_waitcnt vmcnt(0)" ::: "memory");
            const unsigned og = xb_add(&bar[XB_TOP], 1u);
            const unsigned tg = og / nx;
            if (og + 1u == (tg + 1u) * nx) xb_add(&bar[XB_TOPGEN], 1u);
            else XB_SPIN(xb_ld(&bar[XB_TOPGEN]) == tg, bar);
            __builtin_amdgcn_fence(__ATOMIC_ACQUIRE, "agent");
            xb_add(&bar[XB_XGEN(b.x)], 1u);
            asm volatile("s_waitcnt vmcnt(0)" ::: "memory");
        } else {
            XB_SPIN(xb_ld(&bar[XB_XGEN(b.x)]) == gen, bar);
            __builtin_amdgcn_fence(__ATOMIC_ACQUIRE, "agent");
            asm volatile("s_waitcnt vmcnt(0)" ::: "memory");
        }
    }
    __syncthreads();
}

struct Args { const float* in[22]; float* out; unsigned char* ws; };
constexpr int PTAB_OFF = 131072, MISC_OFF = 131072 + 256;
__device__ __forceinline__ unsigned long long ldp_raw(LAS unsigned char* lds, int i) { const unsigned long long v = ((volatile LAS unsigned long long*)(lds + PTAB_OFF))[i];
    const unsigned lo = __builtin_amdgcn_readfirstlane((unsigned)v), hi = __builtin_amdgcn_readfirstlane((unsigned)(v >> 32)); return ((unsigned long long)hi << 32) | lo; }
#define GASQ __attribute__((address_space(1)))
#define INP(i) ((const float*)(const GASQ float*)ldp_raw(lds, (i)))
#define OUTP ((float*)(GASQ float*)ldp_raw(lds, 22))
#define WSP ((unsigned char*)(GASQ unsigned char*)ldp_raw(lds, 23))

__device__ __forceinline__ void mod_task(const Args& A, int task, LAS float* ldsf, int tid) {
    const int l = task / 72, cb = task % 72;
    LAS float* sc = ldsf; LAS float* red = ldsf + 5120;
    for (int i = tid; i < 5120; i += NTHREADS) { const int r = i >> 10, k = i & 1023; const float x = r < 4 ? A.in[1][r * 1024 + k] : A.in[3][k]; sc[i] = x / (1.0f + __expf(-x)); }
    __syncthreads();
    const int quad = tid & 31, ks = tid >> 5;
    const float* W = A.in[4] + (size_t)l * D * MODROW + cb * 128 + quad * 4;
    f32x4 acc[5];
#pragma unroll
    for (int r = 0; r < 5; ++r) acc[r] = (f32x4){0.f, 0.f, 0.f, 0.f};
#pragma unroll 16
    for (int kk = 0; kk < 64; ++kk) { const int k = ks * 64 + kk; const f32x4 w = *(const f32x4*)(W + (size_t)k * MODROW);
#pragma unroll
        for (int r = 0; r < 5; ++r) acc[r] += w * sc[r * 1024 + k]; }
#pragma unroll
    for (int r = 0; r < 5; ++r) *(LAS f32x4*)(red + (ks * 5 + r) * 128 + quad * 4) = acc[r];
    __syncthreads();
    float* mod = (float*)(A.ws + WS_MOD);
    for (int i = tid; i < 640; i += NTHREADS) { const int r = i >> 7, col = i & 127; float s = 0.f;
#pragma unroll
        for (int k2 = 0; k2 < 16; ++k2) s += red[(k2 * 5 + r) * 128 + col];
        mod[(size_t)(l * 5 + r) * MODROW + cb * 128 + col] = s + A.in[5][l * MODROW + cb * 128 + col]; }
    __syncthreads();
}

__device__ __forceinline__ void norm_phase(const float* h_lat, const float* h_ctx, int M, const float* gain, const float* modl, int shift_idx, bf16* U, int gw, int ngw, int lane,
                                           const float* part, const float* pgate, float* hc_out) {
    for (int grp = gw; grp < M / 4; grp += ngw) {
        const int row = grp * 4;
        const float* xr = row < NLAT ? h_lat + (size_t)row * D : h_ctx + (size_t)(row - NLAT) * D;
        const int r5 = row < NLAT ? (row >> 13) : 4;
        const f32x4* sh = (const f32x4*)(modl + (size_t)r5 * MODROW + shift_idx * D) + lane; const f32x4* sc = sh + D / 4;
        const f32x4* x4 = (const f32x4*)xr + lane; const f32x4* g4 = (const f32x4*)gain + lane;
        f32x4 v[4][4]; float ss[4];
#pragma unroll
        for (int q = 0; q < 4; ++q)
#pragma unroll
            for (int j = 0; j < 4; ++j) v[q][j] = x4[q * (D / 4) + 64 * j];
        f32x4 gm[4], sf[4];
#pragma unroll
        for (int j = 0; j < 4; ++j) { gm[j] = g4[64 * j] * (sc[64 * j] + 1.0f); sf[j] = sh[64 * j]; }
        if (part != nullptr && row >= NLAT) {
            const f32x4* pg4 = (const f32x4*)pgate + lane;
#pragma unroll
            for (int q = 0; q < 4; ++q) { const f32x4* p4 = (const f32x4*)(part + (size_t)(row - NLAT + q) * D) + lane; f32x4* ho = (f32x4*)(hc_out + (size_t)(row - NLAT + q) * D) + lane;
#pragma unroll
                for (int j = 0; j < 4; ++j) { const f32x4 ps = (p4[64 * j] + p4[64 * j + 262144]) + (p4[64 * j + 2 * 262144] + p4[64 * j + 3 * 262144]);
                    v[q][j] += pg4[64 * j] * 0.5f * ps; ho[64 * j] = v[q][j]; } }
        }
#pragma unroll
        for (int q = 0; q < 4; ++q) { float a = 0.f;
#pragma unroll
            for (int j = 0; j < 4; ++j) a += (v[q][j][0] * v[q][j][0] + v[q][j][1] * v[q][j][1]) + (v[q][j][2] * v[q][j][2] + v[q][j][3] * v[q][j][3]);
            ss[q] = a; }
#pragma unroll
        for (int o = 1; o < 64; o <<= 1) {
#pragma unroll
            for (int q = 0; q < 4; ++q) ss[q] += __shfl_xor(ss[q], o); }
#pragma unroll
        for (int q = 0; q < 4; ++q) { const float rstd = 1.0f / sqrtf(ss[q] * (1.0f / D) + EPS);
            const int rr = row + q; bf16* ob = U + (size_t)(rr >> 8) * 16 * 16384 + (rr & 255) * 64 + (size_t)(lane >> 4) * 16384 + 4 * (lane & 15);
#pragma unroll
            for (int j = 0; j < 4; ++j) { const f32x4 y = v[q][j] * rstd * gm[j] + sf[j]; v2u w; w.x = pk2(y[0], y[1]); w.y = pk2(y[2], y[3]); *(v2u*)(ob + (size_t)j * 4 * 16384) = w; } }
    }
}

__global__ void __launch_bounds__(NTHREADS, 2) fwd_megakernel(Args A) {
    extern __shared__ __attribute__((aligned(16))) unsigned char lds_raw[];
    cg::grid_group grid = cg::this_grid();
    LAS unsigned char* lds0 = (LAS unsigned char*)lds_raw;
    const int wave = __builtin_amdgcn_readfirstlane(threadIdx.x >> 6);
    if (threadIdx.x == 0) { LAS unsigned long long* pt = (LAS unsigned long long*)(lds0 + PTAB_OFF);
#pragma unroll
        for (int i = 0; i < 22; ++i) pt[i] = (unsigned long long)A.in[i];
        pt[22] = (unsigned long long)A.out; pt[23] = (unsigned long long)A.ws;
        ((LAS unsigned*)(lds0 + MISC_OFF))[0] = 0u; ((LAS unsigned*)(lds0 + MISC_OFF))[1] = 0u; }
    __syncthreads();
    (void)xcd_barrier_post((unsigned*)A.ws, (volatile LAS unsigned*)(lds0 + MISC_OFF));

    for (int prep = 0; prep < PRO_REP; ++prep) {
        LAS unsigned char* lds = lds0; const int tid = threadIdx.x, lane = tid & 63;
        const int G = gridDim.x, bx = blockIdx.x, gw = bx * NWAVES + wave, ngw = G * NWAVES;
        unsigned char* ws = A.ws;
        float* cosT = (float*)(ws + WS_COS); float* sinT = (float*)(ws + WS_SIN);
        if (bx < 144) mod_task(A, bx, (LAS float*)lds, tid);
        for (int i = bx * NTHREADS + tid; i < 8192 * 32; i += G * NTHREADS) { const int t = i >> 5, j = i & 31; const float pos = (float)(j < 16 ? (t >> 6) : (t & 63));
            const float inv = exp2f(-(float)(j & 15) * (13.287712379549449f / 16.0f)); float rev = pos * inv * 0.15915494309189535f; rev -= floorf(rev);
            cosT[i] = __builtin_amdgcn_cosf(rev); sinT[i] = __builtin_amdgcn_sinf(rev); }
        LAS float* scr = (LAS float*)(lds + wave * 16384);
        constexpr int I_G = (D / 64) * (FF / 32), I_D = (FF / 64) * (D / 32), I_IN = (D / 64) * (WIN / 32), I_O = (D / 64) * (D / 32);
        constexpr int PER_L = 2 * (2 * I_G + I_D) + I_IN + I_O;
        for (int it = gw; it < DEPTH * PER_L; it += ngw) {
            const int l = it / PER_L; int r = it % PER_L; unsigned char* wl = ws + WS_W + (size_t)l * WL_SIZE;
            if (r < 2 * (2 * I_G + I_D)) {
                const int f = r / (2 * I_G + I_D); r -= f * (2 * I_G + I_D);
                bf16* gu = (bf16*)(wl + (f ? WL_GU2 : WL_GU1)); bf16* dn = (bf16*)(wl + (f ? WL_D2 : WL_D1));
                if (r < 2 * I_G) { const int up = r / I_G; r -= up * I_G; const int nb = FF / 32, kb = r / nb, n0 = (r % nb) * 32;
                    const float* W = (f ? (up ? A.in[19] : A.in[18]) : (up ? A.in[8] : A.in[7])) + (size_t)l * D * FF;
                    transpose_item(W, D, FF, gu, 256 * (n0 >> 7) + (n0 & 127) + 128 * up, kb * 64, n0, scr, lane); }
                else { r -= 2 * I_G; const int nb = D / 32, kb = r / nb, n0 = (r % nb) * 32;
                    const float* W = (f ? A.in[20] : A.in[9]) + (size_t)l * FF * D;
                    transpose_item(W, FF, D, dn, n0, kb * 64, n0, scr, lane); }
            } else { r -= 2 * (2 * I_G + I_D);
                if (r < I_IN) { const int nb = WIN / 32, kb = r / nb, n0 = (r % nb) * 32; const int nl = n0 & 255;
                    const float* W = A.in[11] + (size_t)l * D * WIN;
                    transpose_item(W, D, WIN, (bf16*)(wl + WL_IN), (n0 & ~255) + 128 * ((nl & 63) >> 5) + 32 * (nl >> 6), kb * 64, n0, scr, lane); }
                else { r -= I_IN; const int nb = D / 32, kb = r / nb, n0 = (r % nb) * 32;
                    const float* W = A.in[16] + (size_t)l * D * D;
                    transpose_item(W, D, D, (bf16*)(wl + WL_OUT), n0, kb * 64, n0, scr, lane); }
            }
        }
        if (PRO_REP > 1) __syncthreads();
    }
    if (gridDim.x == 0x7fffffffu) grid.sync();
    GSYNC();

#define GW_DECL unsigned opq_; asm volatile("s_mov_b32 %0, 0" : "=s"(opq_)); LAS unsigned char* lds = lds0 + opq_; int lane = (int)(threadIdx.x & 63); asm volatile("" : "+v"(lane)); int G = gridDim.x, bx = blockIdx.x; asm volatile("" : "+s"(G), "+s"(bx)); int wave = __builtin_amdgcn_readfirstlane(threadIdx.x >> 6); asm volatile("" : "+s"(wave)); unsigned char* ws = WSP
#define NORM_ARGS const int gw = bx * NWAVES + wave, ngw = G * NWAVES
#pragma unroll 1
    for (int l = 0; l < DEPTH; ++l) {
        { GW_DECL; NORM_ARGS; const float* src_lat = l == 0 ? INP(0) : (const float*)OUTP; const float* src_ctx = l == 0 ? INP(2) : (const float*)(ws + WS_HC);
          for (int nrep = 0; nrep < NORM_REP; ++nrep) norm_phase(src_lat, src_ctx, MFULL, INP(6) + l * D, (const float*)(ws + WS_MOD) + (size_t)l * 5 * MODROW, 0, (bf16*)(ws + WS_U), gw, ngw, lane,
                     l == 0 ? (const float*)nullptr : (const float*)(ws + WS_PART), (const float*)(ws + WS_MOD) + 4 * MODROW + 8 * D, (float*)(ws + WS_HC)); }
        GSYNC();
#if PM & 1
        { GW_DECL; pg8::Gemm g{(const bf16*)(ws + WS_U), (const bf16*)(ws + WS_W + (size_t)l * WL_SIZE + WL_GU1), MFULL, 2 * FF, D}; pg8::StaticOrder S; S.init(MFULL, 2 * FF, G, bx, D);
          pg8::EpiSwiGLU E{(bf16*)(ws + WS_HID), FF}; pg8::gemm_phase<pg8::EpiSwiGLU, pg8::StaticOrder, true, true>(lds, g, S, E); }
#endif
        GSYNC();
#if PM & 2
        for (int rep = 0; rep < ((l == 0) ? G2_REP : 1); ++rep)
        { GW_DECL; float* hl = OUTP; float* hc = (float*)(ws + WS_HC); const float* src_lat = l == 0 ? INP(0) : (const float*)hl; const float* src_ctx = l == 0 ? INP(2) : (const float*)hc;
          pg8::Gemm g{(const bf16*)(ws + WS_HID), (const bf16*)(ws + WS_W + (size_t)l * WL_SIZE + WL_D1), MFULL, D, FF}; pg8::CtxSplitOrder S; S.init(G, bx, FF, 64, NLAT, 0, rep ? G2_PMMASK : 0x7fffffff);
          pg8::EpiRes E{src_lat, src_ctx, rep ? (float*)(ws + WS_DUMMY) : hl, hc, (const float*)(ws + WS_MOD) + (size_t)l * 5 * MODROW + 2 * D, 0.5f, (float*)(ws + WS_PART)}; pg8::gemm_phase<pg8::EpiRes, pg8::CtxSplitOrder, true, true>(lds, g, S, E); }
#endif
        GSYNC();
        { GW_DECL; NORM_ARGS;
          for (int nrep = 0; nrep < NORM_REP; ++nrep) norm_phase(OUTP, l == 0 ? INP(2) : (const float*)(ws + WS_HC), MFULL, INP(10) + l * D, (const float*)(ws + WS_MOD) + (size_t)l * 5 * MODROW, 3, (bf16*)(ws + WS_U), gw, ngw, lane,
                     (const float*)(ws + WS_PART), (const float*)(ws + WS_MOD) + (size_t)l * 5 * MODROW + 4 * MODROW + 2 * D, (float*)(ws + WS_HC)); }
        GSYNC();
#if PM & 4
        for (int rep = 0; rep < ((l == 0) ? G3_REP : 1); ++rep)
        { GW_DECL; pg8::Gemm g{(const bf16*)(ws + WS_U), (const bf16*)(ws + WS_W + (size_t)l * WL_SIZE + WL_IN), MFULL, WIN, D}; pg8::StaticOrder S; S.init(MFULL, WIN, G, bx, D);
          pg8::EpiQKV E{(bf16*)(ws + WS_HID), WIN, INP(12) + l * 64, INP(13) + l * 64, (const float*)(ws + WS_COS), (const float*)(ws + WS_SIN)};
          pg8::gemm_phase<pg8::EpiQKV, pg8::StaticOrder, true, true>(lds, g, S, E); }
#endif
        GSYNC();
#if PM & 8
        { GW_DECL; const int nunits = (l == DEPTH - 1) ? 2048 : 2112; const float* sink_l = INP(14) + l * 6; const float* rpb_l = INP(15) + (size_t)l * 6 * 465; const float* qn_l = INP(12) + l * 64; const float* kn_l = INP(13) + l * 64;
          const bf16* P = (const bf16*)(ws + WS_HID); bf16* Y = (bf16*)(ws + WS_U);
#pragma unroll 1
          for (int v = bx; v < nunits + ATT_EXTRA; v += G) att::attn_unit(v < nunits ? v : v - nunits, sink_l, P, Y, lds, rpb_l, qn_l, kn_l); }
#endif
        GSYNC();
#if PM & 16
        { GW_DECL; const int M2 = (l == DEPTH - 1) ? NLAT : MFULL; float* hl = OUTP; float* hc = (float*)(ws + WS_HC);
          pg8::Gemm g{(const bf16*)(ws + WS_U), (const bf16*)(ws + WS_W + (size_t)l * WL_SIZE + WL_OUT), M2, D, D}; pg8::StaticOrder S; S.init(M2, D, G, bx, D);
          pg8::EpiRes E{hl, hc, hl, hc, (const float*)(ws + WS_MOD) + (size_t)l * 5 * MODROW + 5 * D, 1.0f, nullptr}; pg8::gemm_phase<pg8::EpiRes, pg8::StaticOrder, true, true>(lds, g, S, E); }
#endif
        GSYNC();
        { GW_DECL; NORM_ARGS; const int M2 = (l == DEPTH - 1) ? NLAT : MFULL;
          for (int nrep = 0; nrep < NORM_REP; ++nrep) norm_phase(OUTP, (const float*)(ws + WS_HC), M2, INP(17) + l * D, (const float*)(ws + WS_MOD) + (size_t)l * 5 * MODROW, 6, (bf16*)(ws + WS_U), gw, ngw, lane, (const float*)nullptr, (const float*)nullptr, (float*)nullptr); }
        GSYNC();
#if PM & 32
        { GW_DECL; const int M2 = (l == DEPTH - 1) ? NLAT : MFULL;
          pg8::Gemm g{(const bf16*)(ws + WS_U), (const bf16*)(ws + WS_W + (size_t)l * WL_SIZE + WL_GU2), M2, 2 * FF, D}; pg8::StaticOrder S; S.init(M2, 2 * FF, G, bx, D);
          pg8::EpiSwiGLU E{(bf16*)(ws + WS_HID), FF}; pg8::gemm_phase<pg8::EpiSwiGLU, pg8::StaticOrder, true, true>(lds, g, S, E); }
#endif
        GSYNC();
#if PM & 64
        { GW_DECL; const int M2 = (l == DEPTH - 1) ? NLAT : MFULL; float* hl = OUTP; float* hc = (float*)(ws + WS_HC);
          pg8::Gemm g{(const bf16*)(ws + WS_HID), (const bf16*)(ws + WS_W + (size_t)l * WL_SIZE + WL_D2), M2, D, FF}; pg8::CtxSplitOrder S; S.init(G, bx, FF, M2 == MFULL ? 64 : 0, NLAT, 0, 0x7fffffff);
          pg8::EpiRes E{hl, hc, hl, hc, (const float*)(ws + WS_MOD) + (size_t)l * 5 * MODROW + 8 * D, 0.5f, (float*)(ws + WS_PART)}; pg8::gemm_phase<pg8::EpiRes, pg8::CtxSplitOrder, true, true>(lds, g, S, E); }
#endif
        GSYNC();
    }
    { GW_DECL; NORM_ARGS; float* hl = OUTP; const float* gf = INP(21); (void)ws;
      for (int grp = gw; grp < NLAT / 4; grp += ngw) {
        f32x4* x4 = (f32x4*)(hl + (size_t)grp * 4 * D) + lane; const f32x4* g4 = (const f32x4*)gf + lane;
        f32x4 v[4][4]; float ss[4];
#pragma unroll
        for (int q = 0; q < 4; ++q)
#pragma unroll
            for (int j = 0; j < 4; ++j) v[q][j] = x4[q * (D / 4) + 64 * j];
#pragma unroll
        for (int q = 0; q < 4; ++q) { float a = 0.f;
#pragma unroll
            for (int j = 0; j < 4; ++j) a += (v[q][j][0] * v[q][j][0] + v[q][j][1] * v[q][j][1]) + (v[q][j][2] * v[q][j][2] + v[q][j][3] * v[q][j][3]);
            ss[q] = a; }
#pragma unroll
        for (int o = 1; o < 64; o <<= 1) {
#pragma unroll
            for (int q = 0; q < 4; ++q) ss[q] += __shfl_xor(ss[q], o); }
#pragma unroll
        for (int q = 0; q < 4; ++q) { const float rstd = 1.0f / sqrtf(ss[q] * (1.0f / D) + EPS);
#pragma unroll
            for (int j = 0; j < 4; ++j) x4[q * (D / 4) + 64 * j] = v[q][j] * rstd * g4[64 * j]; }
      } }
}

extern "C" void kernel_launch(void* const* d_in, const int* in_sizes, int n_in, void* d_out, int out_size, void* d_ws, size_t ws_size, hipStream_t stream) {
    static int grid_blocks = 0;
    if (grid_blocks == 0) {
        if (n_in != 22 || out_size != NLAT * D || ws_size < WS_END) { fprintf(stderr, "kernel_launch: unexpected shapes (n_in %d out %d ws %zu)\n", n_in, out_size, ws_size); grid_blocks = -1; return; }
        int dev = 0, cus = 0, per_cu = 0;
        hipGetDevice(&dev); hipDeviceGetAttribute(&cus, hipDeviceAttributeMultiprocessorCount, dev);
        if (hipFuncSetAttribute((const void*)fwd_megakernel, hipFuncAttributeMaxDynamicSharedMemorySize, LDS_BYTES) != hipSuccess) { fprintf(stderr, "hipFuncSetAttribute failed\n"); grid_blocks = -1; return; }
        if (hipOccupancyMaxActiveBlocksPerMultiprocessor(&per_cu, (const void*)fwd_megakernel, NTHREADS, LDS_BYTES) != hipSuccess || per_cu < 1) per_cu = 1;
        (void)hipGetLastError();
        grid_blocks = cus * per_cu;
        fprintf(stderr, "kernel_launch: %d CUs x %d = grid %d\n", cus, per_cu, grid_blocks);
    }
    if (grid_blocks < 0) return;
    if (hipMemsetAsync(d_ws, 0, 65536, stream) != hipSuccess) { fprintf(stderr, "memset failed\n"); return; }
    Args a{};
    for (int i = 0; i < 22; ++i) a.in[i] = (const float*)d_in[i];
    a.out = (float*)d_out; a.ws = (unsigned char*)d_ws;
    void* args[] = {&a};
    hipError_t e = hipLaunchCooperativeKernel((const void*)fwd_megakernel, dim3(grid_blocks), dim3(NTHREADS), args, LDS_BYTES, stream);
    if (e != hipSuccess) fprintf(stderr, "cooperative launch failed: %s (grid %d)\n", hipGetErrorString(e), grid_blocks);
}
```

```cpp
#include <hip/hip_runtime.h>
#include <hip/hip_cooperative_groups.h>
#include <cstdio>
#include <cstdint>
namespace cg = cooperative_groups;
namespace pg8 {
#define PG8_LAS __attribute__((address_space(3)))
typedef unsigned short bf16_t;
typedef short bf16x8 __attribute__((ext_vector_type(8)));
typedef float f32x4 __attribute__((ext_vector_type(4)));
typedef unsigned u32x4 __attribute__((ext_vector_type(4)));
constexpr int BM = 256, BK = 64, HALF = 128, HTB = HALF * BK * 2  , STAGE_BYTES = 8 * HTB, NXCD = 8, WGM = 8;

__host__ __device__ __forceinline__ int lds_byte(int r, int c) { const int st = (r >> 4) * 2 + (c >> 5), rr = r & 15, cc = c & 31, ob = rr * 64 + cc * 2; return st * 1024 + (ob ^ (((ob >> 9) & 1) << 5)); }
__host__ __device__ __forceinline__ void stage_rc(int b, int& R, int& C) { const int st = b / 1024, sb = b % 1024, swz = sb ^ (((sb >> 9) & 1) << 5); R = (st >> 1) * 16 + swz / 64; C = (st & 1) * 32 + (swz % 64) / 2; }
__host__ __device__ __forceinline__ int perm32(int rho) { const int n = rho >> 4, i = rho & 15; return 8 * (i >> 2) + 4 * n + (i & 3); }

struct Unit { int pm, pn, k0t, nt, ks; };
struct Gemm { const bf16_t* A; const bf16_t* Bt; int M, N, K; };

struct StaticOrder {
    int nM, nN, nwg, G, c, ntk, pmoff;
    __host__ __device__ __forceinline__ void init(int M, int N, int G_, int c_, int K_, int pmoff_ = 0) { nM = M / BM; nN = N / BM; nwg = nM * nN; G = G_; c = c_; ntk = K_ / BK; pmoff = pmoff_; }
    __host__ __device__ __forceinline__ bool next(int i, Unit& u) const {
        const long L = (long)i * G + c; if (L >= nwg) return false;
        int wgid = (int)L; { const int q = nwg / NXCD, r = nwg % NXCD, xcd = wgid % NXCD, off = wgid / NXCD; wgid = (xcd < r ? xcd * (q + 1) : r * (q + 1) + (xcd - r) * q) + off; }
        const int nig = WGM * nN, gid = wgid / nig, fm = gid * WGM, gsz = (nM - fm) < WGM ? (nM - fm) : WGM;
        u.pm = pmoff + fm + ((wgid % nig) % gsz); u.pn = (wgid % nig) / gsz; u.k0t = 0; u.nt = ntk; u.ks = -1; return true;
    }
    __device__ __forceinline__ void a_ready(const Unit&) const {}
    __device__ __forceinline__ void done(const Unit&) const {}
};

#ifndef REV_ORDER
#define REV_ORDER 1
#endif
struct CtxSplitOrder {
    StaticOrder lat; int G, c, nsub, pmmask;
    __host__ __device__ __forceinline__ void init(int G_, int c_, int K_, int nsub_, int latM, int pmoff_, int pmmask_) { lat.init(latM, 1024, G_, c_, K_, pmoff_); G = G_; c = c_; nsub = nsub_; pmmask = pmmask_; }
    __host__ __device__ __forceinline__ bool next(int i, Unit& u) const {
        const int L = i * G + c; const bool islat = L < lat.nwg;
        const int Ll = islat ? L : 0;
        int wgid = Ll; { const int q = lat.nwg / NXCD, r = lat.nwg % NXCD, xcd = wgid % NXCD, off = wgid / NXCD; wgid = (xcd < r ? xcd * (q + 1) : r * (q + 1) + (xcd - r) * q) + off; }
        wgid = REV_ORDER ? (lat.nwg - 1 - wgid) : wgid;
        const int nig = WGM * lat.nN, gid = wgid / nig, fm = gid * WGM, gsz = (lat.nM - fm) < WGM ? (lat.nM - fm) : WGM;
        const int lpm = lat.pmoff + fm + ((wgid % nig) % gsz), lpn = (wgid % nig) / gsz;
        const int j = islat ? 0 : L - lat.nwg, ks = j & 3;
        u.pm = islat ? (lpm & pmmask) : 128 + (j >> 4); u.pn = islat ? lpn : (j >> 2) & 3; u.ks = islat ? -1 : ks;
        u.k0t = islat ? 0 : ks * 12 - (ks == 3 ? 2 : 0); u.nt = islat ? lat.ntk : 12 - 2 * (ks >> 1);
        return islat || (L - lat.nwg) < nsub;
    }
    __device__ __forceinline__ void a_ready(const Unit&) const {}
    __device__ __forceinline__ void done(const Unit&) const {}
};

__device__ __forceinline__ unsigned cvt_pk_bf16(float lo, float hi) { unsigned r; asm volatile("v_cvt_pk_bf16_f32 %0, %1, %2" : "=v"(r) : "v"(lo), "v"(hi)); return r; }
typedef float f32x2 __attribute__((ext_vector_type(2)));
constexpr int D_MODEL = 1024, N_LAT = 32768, MODROW = 9216;
__device__ __forceinline__ unsigned cvt_pk_nv(float lo, float hi) { unsigned r; asm("v_cvt_pk_bf16_f32 %0, %1, %2" : "=v"(r) : "v"(lo), "v"(hi)); return r; }
__device__ __forceinline__ float silu_mul(float g, float u) { return g * __builtin_amdgcn_rcpf(1.0f + __builtin_amdgcn_exp2f(-1.4426950408889634f * g)) * u; }

__device__ __forceinline__ f32x4 silu_mul4(f32x4 g, f32x4 u) {
    f32x4 t = g * (-1.4426950408889634f), gu = g * u;
#pragma unroll
    for (int i = 0; i < 4; ++i) t[i] = __builtin_amdgcn_exp2f(t[i]);
    t = t + 1.0f;
#pragma unroll
    for (int i = 0; i < 4; ++i) t[i] = __builtin_amdgcn_rcpf(t[i]);
    return gu * t;
}
struct EpiSwiGLU {
    static constexpr bool PERM = true, AFTER_DRAIN = false;
    bf16_t* O; int ldc;
    __device__ __forceinline__ void operator()(const f32x4 (&acc)[2][2][4][2], const Unit& u, int wr, int wc, int fr, int fq) const {
        const int row0 = u.pm * BM + wr * 64 + fr, col0 = u.pn * HALF + wc * 32 + 8 * fq;
#pragma unroll
        for (int ai = 0; ai < 2; ++ai)
#pragma unroll
            for (int m = 0; m < 4; ++m) { const int rr = row0 + ai * HALF + m * 16; bf16_t* rowp = O + ((size_t)(rr >> 8) * (ldc >> 6) + (col0 >> 6)) * 16384 + (rr & 255) * 64 + (col0 & 63);
                const f32x4 h0 = silu_mul4(acc[ai][0][m][0], acc[ai][1][m][0]), h1 = silu_mul4(acc[ai][0][m][1], acc[ai][1][m][1]);
                u32x4 w; w.x = cvt_pk_nv(h0[0], h0[1]); w.y = cvt_pk_nv(h0[2], h0[3]); w.z = cvt_pk_nv(h1[0], h1[1]); w.w = cvt_pk_nv(h1[2], h1[3]);
                __builtin_nontemporal_store(w, (u32x4*)rowp); }
    }
};

struct EpiRes {
    static constexpr bool PERM = false, AFTER_DRAIN = false;
    const float* base_lat; const float* base_ctx; float* out_lat; float* out_ctx; const float* gate; float s; float* part;
    __device__ __forceinline__ void operator()(const f32x4 (&acc)[2][2][4][2], const Unit& u, int wr, int wc, int fr, int fq) const {
        if (u.ks >= 0) {
            float* pp = part + (size_t)u.ks * 1024 * 1024 + (size_t)(u.pm * BM - N_LAT + wr * 64 + fr) * D_MODEL + u.pn * BM + wc * 32 + 4 * fq;
#pragma unroll
            for (int ai = 0; ai < 2; ++ai)
#pragma unroll
                for (int m = 0; m < 4; ++m)
#pragma unroll
                    for (int bj = 0; bj < 2; ++bj)
#pragma unroll
                        for (int n = 0; n < 2; ++n) *(f32x4*)(pp + (size_t)(ai * HALF + m * 16) * D_MODEL + bj * HALF + n * 16) = acc[ai][bj][m][n];
            return;
        }
        const bool lat = u.pm < (N_LAT / BM);
        const int r5 = lat ? (u.pm >> 5) : 4;
        const float* g = gate + (size_t)r5 * MODROW;
        const int rowt = (lat ? u.pm * BM : u.pm * BM - N_LAT) + wr * 64 + fr;
        const float* bp = lat ? base_lat : base_ctx; float* op = lat ? out_lat : out_ctx;
        const int col0 = u.pn * BM + wc * 32 + 4 * fq;
        f32x4 gv[2][2];
#pragma unroll
        for (int bj = 0; bj < 2; ++bj)
#pragma unroll
            for (int n = 0; n < 2; ++n) gv[bj][n] = *(const f32x4*)(g + col0 + bj * HALF + n * 16) * s;
#pragma unroll
        for (int ai = 0; ai < 2; ++ai) {
            f32x4 b[4][2][2];
#pragma unroll
            for (int m = 0; m < 4; ++m) { const size_t off = (size_t)(rowt + ai * HALF + m * 16) * D_MODEL + col0;
#pragma unroll
                for (int bj = 0; bj < 2; ++bj)
#pragma unroll
                    for (int n = 0; n < 2; ++n) b[m][bj][n] = *(const f32x4*)(bp + off + bj * HALF + n * 16); }
#pragma unroll
            for (int m = 0; m < 4; ++m) { const size_t off = (size_t)(rowt + ai * HALF + m * 16) * D_MODEL + col0;
#pragma unroll
                for (int bj = 0; bj < 2; ++bj)
#pragma unroll
                    for (int n = 0; n < 2; ++n) *(f32x4*)(op + off + bj * HALF + n * 16) = b[m][bj][n] + gv[bj][n] * acc[ai][bj][m][n]; }
        }
    }
};

struct EpiQKV {
    static constexpr bool PERM = true, AFTER_DRAIN = false;
    bf16_t* O; int ldc; const float* qn; const float* kn; const float* cosT; const float* sinT;
    __device__ __forceinline__ void operator()(const f32x4 (&acc)[2][2][4][2], const Unit& u, int wr, int wc, int fr, int fq) const {
        const int hd = u.pn * 4 + wc;
        const bool lat = u.pm < (N_LAT / BM);
        const bool rope = lat && (hd < 10 || hd == 16 || hd == 17 || hd == 20 || hd == 21);
        const bool qnorm = (hd >= 6 && hd < 10), knorm = (hd == 20 || hd == 21);
        const float qs = hd < 16 ? 0.125f * 1.4426950408889634f : 1.0f;
        const int row0 = u.pm * BM + wr * 64 + fr, col0 = u.pn * BM + wc * 64 + 8 * fq;
        f32x4 gn[2][2];
        if (qnorm || knorm) { const float* gp = (qnorm ? qn : kn) + 8 * fq;
#pragma unroll
            for (int bj = 0; bj < 2; ++bj)
#pragma unroll
                for (int n = 0; n < 2; ++n) gn[bj][n] = *(const f32x4*)(gp + bj * 32 + n * 4); }
#pragma unroll
        for (int am = 0; am < 4; ++am) { const int ai = am >> 1;
            f32x4 cs[4][2], sn[4][2];
            if (rope) {
#pragma unroll
                for (int m = 2 * (am & 1); m < 2 * (am & 1) + 2; ++m) { const int t = (row0 + ai * HALF + m * 16) & 8191;
#pragma unroll
                    for (int n = 0; n < 2; ++n) { cs[m][n] = *(const f32x4*)(cosT + t * 32 + 8 * fq + 4 * n); sn[m][n] = *(const f32x4*)(sinT + t * 32 + 8 * fq + 4 * n); } }
            }
#pragma unroll
            for (int m = 2 * (am & 1); m < 2 * (am & 1) + 2; ++m) {
                const int row = row0 + ai * HALF + m * 16;
                f32x4 x[2][2];
#pragma unroll
                for (int bj = 0; bj < 2; ++bj)
#pragma unroll
                    for (int n = 0; n < 2; ++n) x[bj][n] = acc[ai][bj][m][n];
                if (qnorm || knorm) {
                    float ss = 0.f;
#pragma unroll
                    for (int bj = 0; bj < 2; ++bj)
#pragma unroll
                        for (int n = 0; n < 2; ++n) ss += (x[bj][n][0] * x[bj][n][0] + x[bj][n][1] * x[bj][n][1]) + (x[bj][n][2] * x[bj][n][2] + x[bj][n][3] * x[bj][n][3]);
                    ss += __shfl_xor(ss, 16); ss += __shfl_xor(ss, 32);
                    const float rs = __builtin_amdgcn_rsqf(ss * (1.0f / 64.0f) + 1e-6f);
#pragma unroll
                    for (int bj = 0; bj < 2; ++bj)
#pragma unroll
                        for (int n = 0; n < 2; ++n) x[bj][n] = x[bj][n] * rs * gn[bj][n];
                }
                if (rope) {
#pragma unroll
                    for (int n = 0; n < 2; ++n) { const f32x4 c = cs[m][n], s = sn[m][n];
                        const f32x4 a = x[0][n], b = x[1][n]; x[0][n] = a * c - b * s; x[1][n] = b * c + a * s; }
                }
                bf16_t* rowp = O + (size_t)row * ldc + col0;
#pragma unroll
                for (int bj = 0; bj < 2; ++bj) { const f32x4 v0 = x[bj][0] * qs, v1 = x[bj][1] * qs;
                    u32x4 w; w.x = cvt_pk_bf16(v0[0], v0[1]); w.y = cvt_pk_bf16(v0[2], v0[3]); w.z = cvt_pk_bf16(v1[0], v1[1]); w.w = cvt_pk_bf16(v1[2], v1[3]);
                    *(u32x4*)(rowp + bj * 32) = w; }
            }
        }
    }
};

template <class Epi, class Sched, bool ALIGN_EPI = false, bool SP2 = false>
__device__ __forceinline__ void gemm_phase(PG8_LAS unsigned char* lds, const Gemm g, const Sched& S, const Epi& E) {
    int tid = threadIdx.x; asm volatile("" : "+v"(tid)); const int wid = __builtin_amdgcn_readfirstlane(tid >> 6), lane = tid & 63, wr = wid >> 2, wc = wid & 3, fr = lane & 15, fq = lane >> 4;
    const int K = g.K;
    unsigned voffA[2], voffB[2];
#pragma unroll
    for (int i = 0; i < 2; ++i) { int R, C; stage_rc(tid * 16 + i * 8192, R, C); const int Rb = Epi::PERM ? ((R & ~31) + perm32(R & 31)) : R;
        voffA[i] = (unsigned)(R * BK + C) * 2u; voffB[i] = (unsigned)(Rb * BK + C) * 2u; }
    const size_t kstep = (size_t)(BM * BK * 2);
    const size_t hstep = (size_t)HALF * BK * 2;
    const size_t tstep = (size_t)BM * K * 2;
    const unsigned ldsw = (unsigned)wid * 1024u;
    const int aoff = lds_byte(wr * 64 + fr, fq * 8), boff = lds_byte(wc * 32 + fr, fq * 8);
#define PG8_SA(b, h) (((b) * 2 + (h)) * HTB)
#define PG8_SB(b, h) ((4 + (b) * 2 + (h)) * HTB)
#define PG8_STAGE(bufoff, gbase, voff) do { _Pragma("unroll") for (int _i = 0; _i < 2; ++_i) \
        __builtin_amdgcn_global_load_lds((const unsigned*)((const char*)(gbase) + (voff)[_i]), (PG8_LAS unsigned*)(lds + (bufoff) + ldsw + _i * 8192), 16, 0, 0); } while (0)
#define PG8_LDA(dst, b, h) do { _Pragma("unroll") for (int m = 0; m < 4; ++m) _Pragma("unroll") for (int k = 0; k < 2; ++k) dst[m][k] = *(const PG8_LAS bf16x8*)(lds + PG8_SA(b, h) + aoff + m * 2048 + k * 1024); } while (0)
#define PG8_LDB(dst, b, h) do { _Pragma("unroll") for (int n = 0; n < 2; ++n) _Pragma("unroll") for (int k = 0; k < 2; ++k) dst[n][k] = *(const PG8_LAS bf16x8*)(lds + PG8_SB(b, h) + boff + n * 2048 + k * 1024); } while (0)
#define PG8_MMA(ai, bj, At, Bt) do { __builtin_amdgcn_s_setprio(1); _Pragma("unroll") for (int m = 0; m < 4; ++m) _Pragma("unroll") for (int n = 0; n < 2; ++n) _Pragma("unroll") for (int k = 0; k < 2; ++k) \
        acc[ai][bj][m][n] = __builtin_amdgcn_mfma_f32_16x16x32_bf16(Bt[n][k], At[m][k], acc[ai][bj][m][n], 0, 0, 0); __builtin_amdgcn_s_setprio(0); } while (0)
#define PG8_WAIT_V(n) asm volatile("s_waitcnt vmcnt(" #n ")" ::: "memory")
#define PG8_WAIT_L(n) asm volatile("s_waitcnt lgkmcnt(" #n ")" ::: "memory")
#define PG8_BAR __builtin_amdgcn_s_barrier()
#define PG8_SCHED __builtin_amdgcn_sched_barrier(0)
    Unit cur, nxt; int ui = 0;
    if (!S.next(0, cur)) return;
    f32x4 acc[2][2][4][2];
#pragma unroll
    for (int a = 0; a < 2; ++a)
#pragma unroll
        for (int b = 0; b < 2; ++b)
#pragma unroll
            for (int m = 0; m < 4; ++m)
#pragma unroll
                for (int n = 0; n < 2; ++n) acc[a][b][m][n] = (f32x4){0.f, 0.f, 0.f, 0.f};
    bf16x8 At[4][2], B0[2][2], B1[2][2];
    const char* cA = (const char*)g.A + (size_t)cur.pm * tstep + (size_t)cur.k0t * kstep; const char* cB = (const char*)g.Bt + (size_t)cur.pn * tstep + (size_t)cur.k0t * kstep;
    S.a_ready(cur);
    if constexpr (SP2) {
        PG8_STAGE(PG8_SB(0, 0), cB, voffB); PG8_STAGE(PG8_SB(0, 1), cB + hstep, voffB); PG8_STAGE(PG8_SA(0, 0), cA, voffA); PG8_STAGE(PG8_SA(0, 1), cA + hstep, voffA);
        if (wr == 1) PG8_BAR;
        PG8_WAIT_V(2); PG8_BAR;
        PG8_STAGE(PG8_SB(1, 0), cB + kstep, voffB); PG8_STAGE(PG8_SA(1, 0), cA + kstep, voffA); PG8_STAGE(PG8_SB(1, 1), cB + hstep + kstep, voffB);
        PG8_WAIT_V(6); PG8_BAR;
    } else {
        PG8_STAGE(PG8_SB(0, 0), cB, voffB); PG8_STAGE(PG8_SA(0, 0), cA, voffA); PG8_STAGE(PG8_SB(0, 1), cB + hstep, voffB); PG8_STAGE(PG8_SA(0, 1), cA + hstep, voffA);
        if (wr == 1) PG8_BAR;
        PG8_WAIT_V(4); PG8_BAR;
        PG8_STAGE(PG8_SB(1, 0), cB + kstep, voffB); PG8_STAGE(PG8_SA(1, 0), cA + kstep, voffA); PG8_STAGE(PG8_SB(1, 1), cB + hstep + kstep, voffB);
        PG8_WAIT_V(6); PG8_BAR;
    }
    for (;;) {
        const bool has_next = S.next(ui + 1, nxt);
        const char* nA = has_next ? (const char*)g.A + (size_t)nxt.pm * tstep + (size_t)nxt.k0t * kstep : cA; const char* nB = has_next ? (const char*)g.Bt + (size_t)nxt.pn * tstep + (size_t)nxt.k0t * kstep : cB;
        const int nt = cur.nt;
        for (int t = 0; t < nt; t += 2) {
            const bool last = (t == nt - 2);
            const char* a1 = cA + (size_t)(t + 1) * kstep;
            const char* a2 = last ? nA : cA + (size_t)(t + 2) * kstep; const char* b2 = last ? nB : cB + (size_t)(t + 2) * kstep;
            const char* a3 = a2 + kstep; const char* b3 = b2 + kstep;
            if (last && has_next) S.a_ready(nxt);
            if constexpr (SP2) {
            PG8_LDB(B0, 0, 0); PG8_LDB(B1, 0, 1); PG8_SCHED; PG8_LDA(At, 0, 0); PG8_STAGE(PG8_SA(1, 1), a1 + hstep, voffA);
            PG8_WAIT_V(8); PG8_WAIT_L(0); PG8_BAR; PG8_MMA(0, 0, At, B0); PG8_MMA(0, 1, At, B1); PG8_BAR; PG8_SCHED;
            PG8_LDA(At, 0, 1); PG8_STAGE(PG8_SB(0, 0), b2, voffB); PG8_STAGE(PG8_SB(0, 1), b2 + hstep, voffB); PG8_STAGE(PG8_SA(0, 0), a2, voffA);
            PG8_WAIT_V(8); PG8_WAIT_L(0); PG8_BAR; PG8_MMA(1, 0, At, B0); PG8_MMA(1, 1, At, B1); PG8_BAR; PG8_SCHED;
            PG8_LDB(B0, 1, 0); PG8_LDB(B1, 1, 1); PG8_SCHED; PG8_LDA(At, 1, 0); PG8_STAGE(PG8_SA(0, 1), a2 + hstep, voffA);
            PG8_WAIT_V(8); PG8_WAIT_L(0); PG8_BAR; PG8_MMA(0, 0, At, B0); PG8_MMA(0, 1, At, B1); PG8_BAR; PG8_SCHED;
            PG8_LDA(At, 1, 1); PG8_STAGE(PG8_SB(1, 0), b3, voffB); PG8_STAGE(PG8_SB(1, 1), b3 + hstep, voffB); PG8_STAGE(PG8_SA(1, 0), a3, voffA);
            PG8_WAIT_V(8); PG8_WAIT_L(0); PG8_BAR; PG8_MMA(1, 0, At, B0); PG8_MMA(1, 1, At, B1); PG8_BAR; PG8_SCHED;
            } else {
            PG8_LDB(B0, 0, 0); PG8_SCHED; PG8_LDA(At, 0, 0); PG8_STAGE(PG8_SA(1, 1), a1 + hstep, voffA);
            PG8_WAIT_L(8); PG8_BAR; PG8_WAIT_L(0); PG8_MMA(0, 0, At, B0); PG8_BAR; PG8_SCHED;
            PG8_LDB(B1, 0, 1); PG8_STAGE(PG8_SB(0, 0), b2, voffB);
            PG8_BAR; PG8_WAIT_L(0); PG8_MMA(0, 1, At, B1); PG8_BAR;
            PG8_LDA(At, 0, 1); PG8_STAGE(PG8_SA(0, 0), a2, voffA);
            PG8_BAR; PG8_WAIT_L(0); PG8_MMA(1, 0, At, B0); PG8_BAR; PG8_SCHED;
            PG8_STAGE(PG8_SB(0, 1), b2 + hstep, voffB);
            PG8_WAIT_V(6); PG8_BAR; PG8_MMA(1, 1, At, B1); PG8_BAR;
            PG8_LDB(B0, 1, 0); PG8_SCHED; PG8_LDA(At, 1, 0); PG8_STAGE(PG8_SA(0, 1), a2 + hstep, voffA);
            PG8_WAIT_L(8); PG8_BAR; PG8_WAIT_L(0); PG8_MMA(0, 0, At, B0); PG8_BAR; PG8_SCHED;
            PG8_LDB(B1, 1, 1); PG8_STAGE(PG8_SB(1, 0), b3, voffB);
            PG8_BAR; PG8_WAIT_L(0); PG8_MMA(0, 1, At, B1); PG8_BAR;
            PG8_LDA(At, 1, 1); PG8_STAGE(PG8_SA(1, 0), a3, voffA);
            PG8_BAR; PG8_WAIT_L(0); PG8_MMA(1, 0, At, B0); PG8_BAR; PG8_SCHED;
            PG8_STAGE(PG8_SB(1, 1), b3 + hstep, voffB);
            PG8_WAIT_V(6); PG8_BAR; PG8_MMA(1, 1, At, B1); PG8_BAR;
            }
        }
        if constexpr (ALIGN_EPI) { if (wr == 0) PG8_BAR; }
        if constexpr (!Epi::AFTER_DRAIN) { E(acc, cur, wr, wc, fr, fq); S.done(cur); }
        if (!has_next) break;
#pragma unroll
        for (int a = 0; a < 2; ++a)
#pragma unroll
            for (int b = 0; b < 2; ++b)
#pragma unroll
                for (int m = 0; m < 4; ++m)
#pragma unroll
                    for (int n = 0; n < 2; ++n) acc[a][b][m][n] = (f32x4){0.f, 0.f, 0.f, 0.f};
        cur = nxt; cA = nA; cB = nB; ++ui;
        if constexpr (ALIGN_EPI) { if (wr == 1) PG8_BAR; }
    }
    PG8_WAIT_V(0);
    if constexpr (!ALIGN_EPI) { if (wr == 0) PG8_BAR; }
    PG8_BAR;
    if constexpr (Epi::AFTER_DRAIN) { E.fused(acc, cur, wr, wc, fr, fq, lds, wid, lane); S.done(cur); }
#undef PG8_SA
#undef PG8_SB
#undef PG8_STAGE
#undef PG8_LDA
#undef PG8_LDB
#undef PG8_MMA
#undef PG8_WAIT_V
#undef PG8_WAIT_L
#undef PG8_BAR
#undef PG8_SCHED
}
}
namespace att {
#define ATT_LAS __attribute__((address_space(3)))
typedef unsigned short bf16_t;
typedef short bf16x8 __attribute__((ext_vector_type(8)));
typedef short s16x4 __attribute__((ext_vector_type(4)));
typedef float f32x16 __attribute__((ext_vector_type(16)));
typedef unsigned u32x4 __attribute__((ext_vector_type(4)));
typedef unsigned u32x2 __attribute__((ext_vector_type(2)));
constexpr int PITCH = 2304, YPITCH = 1024, NLAT = 32768;
constexpr float LOG2E = 1.4426950408889634f, NEGF = -1e30f;
constexpr int LDS_K = 0, LDS_V = 24576, LDS_TBL = 40960 + 256;
struct AUnit { int mode, qrow0, qpos0, qcol, kcol, vcol, crow0, lrow0, t_lo, t_hi, hb; float sink; };

__device__ __forceinline__ int clampi(int v, int lo, int hi) { return v < lo ? lo : (v > hi ? hi : v); }
__device__ __forceinline__ void decode(int v, const float* sink_l, AUnit& a) {
    a.sink = NEGF; a.hb = 0;
    if (v < 512) { const int xcd = v & 7, slot = (v >> 3) & 31, i = v >> 8, b = xcd >> 1, kvh = xcd & 1, hq = 2 * kvh + i;
        a.mode = 0; a.qrow0 = b * 8192 + slot * 256; a.qpos0 = slot * 256; a.qcol = 384 + 64 * hq; a.kcol = 1280 + 64 * kvh; a.vcol = 1408 + 64 * kvh;
        a.crow0 = NLAT + b * 256; a.lrow0 = b * 8192; a.t_lo = 0; a.t_hi = 128; return; }
    if (v < 1280) { const int w = v - 512, b = w / 192, r = w % 192, hq = r >> 5, qb = r & 31, kvh = hq / 3;
        a.mode = 1; a.qrow0 = b * 8192 + qb * 256; a.qpos0 = qb * 256; a.qcol = 64 * hq; a.kcol = 1024 + 64 * kvh; a.vcol = 1152 + 64 * kvh;
        a.crow0 = NLAT + b * 256; a.lrow0 = b * 8192; a.t_lo = (4 * qb - 2) < 0 ? 0 : (4 * qb - 2); a.t_hi = (4 * qb + 6) > 128 ? 128 : (4 * qb + 6);
        a.sink = sink_l[hq] * LOG2E; return; }
    if (v < 2048) { const int w = v - 1280, b = w / 192, r = w % 192, h = r >> 5, qb = r & 31, r0 = 4 * qb;
        a.mode = 2; a.qrow0 = b * 8192 + qb * 256; a.qpos0 = qb * 256; a.qcol = 640 + 64 * h; a.kcol = 1536 + 64 * h; a.vcol = 1920 + 64 * h;
        a.crow0 = NLAT + b * 256; a.lrow0 = b * 8192; a.t_lo = clampi(r0 - 4, 0, 120); a.t_hi = clampi(r0 - 1, 0, 120) + 8; a.hb = h; return; }
    { const int w = v - 2048, b = w >> 4, hh = w & 15;
        a.mode = 0; a.qrow0 = NLAT + b * 256; a.qpos0 = 0; a.qcol = 64 * hh; a.crow0 = NLAT + b * 256; a.lrow0 = 0; a.t_lo = 0; a.t_hi = 0;
        if (hh < 6) { const int kvh = hh / 3; a.kcol = 1024 + 64 * kvh; a.vcol = 1152 + 64 * kvh; a.sink = sink_l[hh] * LOG2E; }
        else if (hh < 10) { const int kvh = (hh - 6) >> 1; a.kcol = 1280 + 64 * kvh; a.vcol = 1408 + 64 * kvh; }
        else { const int h = hh - 10; a.kcol = 1536 + 64 * h; a.vcol = 1920 + 64 * h; } }
}
__device__ __forceinline__ unsigned pk_bf16(float lo, float hi) { unsigned r; asm volatile("v_cvt_pk_bf16_f32 %0, %1, %2" : "=v"(r) : "v"(lo), "v"(hi)); return r; }
__device__ __forceinline__ s16x4 vtr(const ATT_LAS unsigned char* p) { typedef short v4i16_t __attribute__((ext_vector_type(4)));
    return __builtin_bit_cast(s16x4, __builtin_amdgcn_ds_read_tr16_b64_v4i16((ATT_LAS v4i16_t*)p)); }
__device__ __forceinline__ int crow(int r, int hi) { return (r & 3) + 8 * (r >> 2) + 4 * hi; }

#define ATT_SB() __builtin_amdgcn_sched_barrier(0)
__device__ __forceinline__ float max3f(float x, float y, float z) { return __builtin_fmaxf(__builtin_fmaxf(x, y), z); }
__device__ __forceinline__ float rowmax32(const f32x16& p0, const f32x16& p1) {
    float x = max3f(p0[0], p0[1], p1[0]), y = max3f(p0[2], p0[3], p1[1]); x = max3f(x, p1[2], p1[3]);
#pragma unroll
    for (int r = 4; r < 16; r += 4) { x = max3f(x, p0[r], p0[r + 1]); y = max3f(y, p0[r + 2], p0[r + 3]); x = max3f(x, p1[r], p1[r + 1]); y = max3f(y, p1[r + 2], p1[r + 3]); }
    const float mm = __builtin_fmaxf(x, y);
    auto rr = __builtin_amdgcn_permlane32_swap(__float_as_uint(mm), __float_as_uint(mm), false, false);
    return __builtin_fmaxf(__uint_as_float(rr[0]), __uint_as_float(rr[1]));
}
__device__ __forceinline__ float halfsum(float v) { auto rr = __builtin_amdgcn_permlane32_swap(__float_as_uint(v), __float_as_uint(v), false, false); return __uint_as_float(rr[0]) + __uint_as_float(rr[1]); }

#define ATT_TROW(t) ((t) < 4 ? a.crow0 + 64 * (t) : a.lrow0 + 64 * (a.t_lo + (t) - 4))
#define ATT_KBUF(i) (lds + LDS_K + (i) * 8192)
#define ATT_VBUF(i) (lds + LDS_V + (i) * 8192)
#define ATT_LDK(dst, buf) do { _Pragma("unroll") for (int d0_ = 0; d0_ < 4; ++d0_) { dst[2 * d0_] = *(const ATT_LAS bf16x8*)((buf) + kfrag + d0_ * 2048); dst[2 * d0_ + 1] = *(const ATT_LAS bf16x8*)((buf) + kfrag + d0_ * 2048 + 512); } } while (0)
template <bool NOMAX>
__device__ __forceinline__ void pipe_tiles(const AUnit& a, const int NF, const bf16_t* kg, const bf16_t* vg, const bf16x8 (&qf)[4], ATT_LAS unsigned char* lds,
                                           const int koff, const int voff, const int kfrag, const int vlane, float& m, float& lsum, f32x16& o0, f32x16& o1) {
        const f32x16 zero16 = {};
        u32x4 kreg, vreg; bf16x8 kf[8]; f32x16 c0, c1, e0, e1;
        { const u32x4 k0 = *(const u32x4*)(kg + (size_t)ATT_TROW(0) * PITCH), k1 = *(const u32x4*)(kg + (size_t)ATT_TROW(1) * PITCH);
          *(ATT_LAS u32x4*)(ATT_KBUF(0) + koff) = k0; *(ATT_LAS u32x4*)(ATT_KBUF(1) + koff) = k1; }
        __syncthreads();
        kreg = *(const u32x4*)(kg + (size_t)ATT_TROW(2) * PITCH); vreg = *(const u32x4*)(vg + (size_t)ATT_TROW(0) * PITCH);
        ATT_LDK(kf, ATT_KBUF(0));
        c0 = (f32x16){}; c1 = (f32x16){};
#pragma unroll
        for (int d0 = 0; d0 < 4; ++d0) { c0 = __builtin_amdgcn_mfma_f32_32x32x16_bf16(kf[2 * d0], qf[d0], c0, 0, 0, 0); c1 = __builtin_amdgcn_mfma_f32_32x32x16_bf16(kf[2 * d0 + 1], qf[d0], c1, 0, 0, 0); }
        m = NOMAX ? 0.f : rowmax32(c0, c1);
#pragma unroll
        for (int r = 0; r < 16; ++r) { e0[r] = __builtin_amdgcn_exp2f(c0[r] - m); e1[r] = __builtin_amdgcn_exp2f(c1[r] - m); }
        ATT_LDK(kf, ATT_KBUF(1));
        *(ATT_LAS u32x4*)(ATT_KBUF(2) + koff) = kreg; *(ATT_LAS u32x4*)(ATT_VBUF(0) + voff) = vreg;
        __syncthreads();
        u32x4 kregB = kreg, vregB = vreg;
        kreg = *(const u32x4*)(kg + (size_t)ATT_TROW(3) * PITCH); vreg = *(const u32x4*)(vg + (size_t)ATT_TROW(1) * PITCH);
        int kb2 = 0;
#define ATT_PIN(x) asm volatile("" : "+v"(x))
#define ATT_STEP(t, KW, VW, KL, VL, E0, E1, C0, C1) do { \
            const bool ldk = ((t) + 2 < NF); \
              \
            if (ldk) *(ATT_LAS u32x4*)(ATT_KBUF(kb2) + koff) = KW; \
            *(ATT_LAS u32x4*)(ATT_VBUF((t) & 1) + voff) = VW; \
            if ((t) + 3 < NF) KL = *(const u32x4*)(kg + (size_t)ATT_TROW((t) + 3) * PITCH); \
            if ((t) + 1 < NF) VL = *(const u32x4*)(vg + (size_t)ATT_TROW((t) + 1) * PITCH); \
            const ATT_LAS unsigned char* vb = ATT_VBUF(((t) - 1) & 1) + vlane; \
            s16x4 vlo[4], vh4[4], wlo[4], wh4[4]; \
            _Pragma("unroll") for (int i = 0; i < 4; ++i) { vlo[i] = vtr(vb + i * 1024); vh4[i] = vtr(vb + i * 1024 + 512); } \
            ATT_SB(); \
            u32x4 pw[4]; float sacc = 0.f; \
            _Pragma("unroll") for (int i = 0; i < 8; ++i) { \
                const int d0 = i >> 1; \
                if (i & 1) C1 = __builtin_amdgcn_mfma_f32_32x32x16_bf16(kf[i], qf[d0], d0 == 0 ? zero16 : C1, 0, 0, 0); \
                else       C0 = __builtin_amdgcn_mfma_f32_32x32x16_bf16(kf[i], qf[d0], d0 == 0 ? zero16 : C0, 0, 0, 0); \
                _Pragma("unroll") for (int j = 0; j < 4; ++j) { const int f = 4 * i + j; sacc += (f < 16 ? E0[f & 15] : E1[f & 15]); } \
                ATT_PIN(sacc); \
                _Pragma("unroll") for (int j = 0; j < 2; ++j) { const int f = 4 * i + 2 * j; const float x0 = (f < 16 ? E0[f & 15] : E1[f & 15]), x1 = (f < 16 ? E0[(f + 1) & 15] : E1[(f + 1) & 15]); \
                    pw[(2 * i + j) >> 2][(2 * i + j) & 3] = pk_bf16(x0, x1); } \
                ATT_SB(); \
            } \
            lsum += sacc; \
            float fsc = 1.0f; bool resc = false; \
            if (!NOMAX) { const float rm = rowmax32(C0, C1) - m; resc = __any(rm > 8.0f); \
            if (resc) { const float dl = __builtin_fmaxf(rm, 0.f); m += dl; fsc = __builtin_amdgcn_exp2f(-dl); lsum *= fsc; } \
                _Pragma("unroll") for (int r = 0; r < 16; ++r) { C0[r] -= m; C1[r] -= m; } } \
            ATT_SB(); \
            _Pragma("unroll") for (int i = 0; i < 4; ++i) { wlo[i] = vtr(vb + 4096 + i * 1024); wh4[i] = vtr(vb + 4096 + i * 1024 + 512); }     \
            ATT_SB(); \
            _Pragma("unroll") for (int i = 0; i < 8; ++i) { \
                const int s = i & 3; const bf16x8 pa = __builtin_bit_cast(bf16x8, pw[s]); \
                if (i < 4) { const bf16x8 vf = (bf16x8){vlo[s][0], vlo[s][1], vlo[s][2], vlo[s][3], vh4[s][0], vh4[s][1], vh4[s][2], vh4[s][3]}; \
                    o0 = __builtin_amdgcn_mfma_f32_32x32x16_bf16(vf, pa, o0, 0, 0, 0); } \
                else { const bf16x8 vf = (bf16x8){wlo[s][0], wlo[s][1], wlo[s][2], wlo[s][3], wh4[s][0], wh4[s][1], wh4[s][2], wh4[s][3]}; \
                    o1 = __builtin_amdgcn_mfma_f32_32x32x16_bf16(vf, pa, o1, 0, 0, 0); } \
                if (i < 4) { _Pragma("unroll") for (int j = 0; j < 4; ++j) C0[4 * i + j] = __builtin_amdgcn_exp2f(C0[4 * i + j]); ATT_PIN(C0); } \
                else       { _Pragma("unroll") for (int j = 0; j < 4; ++j) C1[4 * i - 16 + j] = __builtin_amdgcn_exp2f(C1[4 * i - 16 + j]); ATT_PIN(C1); } \
                if (i >= 2 && i < 6) { const int d0 = i - 2; const ATT_LAS unsigned char* kb = ATT_KBUF(kb2 == 0 ? 2 : kb2 - 1); \
                    kf[2 * d0] = *(const ATT_LAS bf16x8*)(kb + kfrag + d0 * 2048); kf[2 * d0 + 1] = *(const ATT_LAS bf16x8*)(kb + kfrag + d0 * 2048 + 512); } \
                ATT_SB(); \
            } \
            if (!NOMAX && resc) { \
                _Pragma("unroll") for (int r = 0; r < 16; ++r) { o0[r] *= fsc; o1[r] *= fsc; } } \
            kb2 = (kb2 == 2) ? 0 : kb2 + 1; \
            __syncthreads(); \
        } while (0)
        if (__builtin_amdgcn_readfirstlane((int)threadIdx.x) >= 256) __builtin_amdgcn_s_setprio(1);
        for (int t = 1; t < NF; t += 2) {
            ATT_STEP(t, kreg, vreg, kregB, vregB, e0, e1, c0, c1);
            if (t + 1 < NF) ATT_STEP(t + 1, kregB, vregB, kreg, vreg, c0, c1, e0, e1);
        }
        __builtin_amdgcn_s_setprio(0);
        if ((NF - 1) & 1) { e0 = c0; e1 = c1; }
#undef ATT_STEP
#undef ATT_PIN
        { u32x4 pw[4]; float sacc = 0.f;
#pragma unroll
          for (int r = 0; r < 16; ++r) sacc += e0[r] + e1[r];
          lsum += sacc;
#pragma unroll
          for (int j = 0; j < 4; ++j) { pw[0][j] = pk_bf16(e0[2 * j], e0[2 * j + 1]); pw[1][j] = pk_bf16(e0[8 + 2 * j], e0[8 + 2 * j + 1]);
                                        pw[2][j] = pk_bf16(e1[2 * j], e1[2 * j + 1]); pw[3][j] = pk_bf16(e1[8 + 2 * j], e1[8 + 2 * j + 1]); }
          const ATT_LAS unsigned char* vb = ATT_VBUF((NF - 1) & 1) + vlane;
#pragma unroll
          for (int s = 0; s < 4; ++s) { const bf16x8 pa = __builtin_bit_cast(bf16x8, pw[s]);
              { const s16x4 lo = vtr(vb + s * 1024), h4 = vtr(vb + s * 1024 + 512); const bf16x8 vf = (bf16x8){lo[0], lo[1], lo[2], lo[3], h4[0], h4[1], h4[2], h4[3]};
                o0 = __builtin_amdgcn_mfma_f32_32x32x16_bf16(vf, pa, o0, 0, 0, 0); }
              { const s16x4 lo = vtr(vb + 4096 + s * 1024), h4 = vtr(vb + 4096 + s * 1024 + 512); const bf16x8 vf = (bf16x8){lo[0], lo[1], lo[2], lo[3], h4[0], h4[1], h4[2], h4[3]};
                o1 = __builtin_amdgcn_mfma_f32_32x32x16_bf16(vf, pa, o1, 0, 0, 0); } }
        }
        __syncthreads();
}

__device__ __forceinline__ void attn_unit(int uv, const float* sink_l, const bf16_t* P, bf16_t* Y, ATT_LAS unsigned char* lds, const float* rpb_l, const float* qn_l, const float* kn_l) {
    AUnit a; decode(uv, sink_l, a);
    int tid = threadIdx.x; asm volatile("" : "+v"(tid)); const int lane = tid & 63, r32 = lane & 31, hi = lane >> 5; const int wid = __builtin_amdgcn_readfirstlane(tid >> 6);
    const int kkey = 8 * wid + (lane & 7), kc = lane >> 3;
    const int vkey = 8 * wid + ((lane >> 2) & 1) + 2 * ((lane >> 4) & 3), vd8 = (lane & 3) + 4 * ((lane >> 3) & 1);
    const int koff = (kc >> 1) * 2048 + (kc & 1) * 1024 + (kkey >> 5) * 512 + (kkey & 31) * 16;
    const int voff = (vd8 >> 2) * 4096 + (vkey >> 3) * 512 + (vkey & 7) * 64 + (vd8 & 3) * 16;
    const bf16_t* kg = P + (size_t)kkey * PITCH + a.kcol + kc * 8;
    const bf16_t* vg = P + (size_t)vkey * PITCH + a.vcol + vd8 * 8;
    ATT_LAS float* tbl = (ATT_LAS float*)(lds + LDS_TBL);
    if (a.mode == 2) { for (int i = tid; i < 465; i += 512) tbl[i] = rpb_l[a.hb * 465 + i] * LOG2E; }
    const int qrow = a.qrow0 + 32 * wid + r32;
    bf16x8 qf[4];
#pragma unroll
    for (int d0 = 0; d0 < 4; ++d0) qf[d0] = *(const bf16x8*)(P + (size_t)qrow * PITCH + a.qcol + 16 * d0 + 8 * hi);
    const int nlat = a.t_hi - a.t_lo;
    const int kfrag = hi * 1024 + r32 * 16;
    const int vlane = ((lane >> 4) & 1) * 32 + (lane & 3) * 8 + (4 * hi + ((lane & 15) >> 2)) * 64;
    float m, lsum = 0.f; f32x16 o0 = {}, o1 = {};
    {
        const int NF = 4 + (a.mode == 0 ? nlat : 0);
        bool nomax = false;
        if (uv < 512) {
            float gq = __builtin_fabsf(qn_l[lane]), gk = __builtin_fabsf(kn_l[lane]);
#pragma unroll
            for (int o = 1; o < 64; o <<= 1) { gq = __builtin_fmaxf(gq, __shfl_xor(gq, o)); gk = __builtin_fmaxf(gk, __shfl_xor(gk, o)); }
            nomax = __builtin_amdgcn_readfirstlane(__float_as_int(gq * gk * (8.0f * LOG2E))) < __float_as_int(40.0f);
        }
        if (nomax) pipe_tiles<true>(a, NF, kg, vg, qf, lds, koff, voff, kfrag, vlane, m, lsum, o0, o1);
        else       pipe_tiles<false>(a, NF, kg, vg, qf, lds, koff, voff, kfrag, vlane, m, lsum, o0, o1);
    }
    if (a.mode != 0 && nlat > 0) {
        u32x4 kreg, vreg;
        { const size_t ro = (size_t)ATT_TROW(4) * PITCH; kreg = *(const u32x4*)(kg + ro); vreg = *(const u32x4*)(vg + ro); }
        *(ATT_LAS u32x4*)(ATT_KBUF(0) + koff) = kreg; *(ATT_LAS u32x4*)(ATT_VBUF(0) + voff) = vreg;
        __syncthreads();
        const int qw = a.qpos0 + 32 * wid, qr = qw >> 6;
        for (int t = 0; t < nlat; ++t) {
            const int cur = t & 1, tl = a.t_lo + t;
            if (t + 1 < nlat) { const size_t ro = (size_t)ATT_TROW(t + 5) * PITCH; kreg = *(const u32x4*)(kg + ro); vreg = *(const u32x4*)(vg + ro); }
            bool need;
            if (a.mode == 1) need = (tl * 64 + 63 >= qw - 128) && (tl * 64 <= qw + 31 + 128);
            else { const int rs = clampi(qr - 4, 0, 120); need = (tl >= rs) && (tl < rs + 8); }
            if (need) {
                const ATT_LAS unsigned char* Kb = ATT_KBUF(cur); const ATT_LAS unsigned char* Vb = ATT_VBUF(cur);
                f32x16 p0 = {}, p1 = {};
#pragma unroll
                for (int d0 = 0; d0 < 4; ++d0) {
                    const bf16x8 k0 = *(const ATT_LAS bf16x8*)(Kb + kfrag + d0 * 2048);
                    const bf16x8 k1 = *(const ATT_LAS bf16x8*)(Kb + kfrag + d0 * 2048 + 512);
                    p0 = __builtin_amdgcn_mfma_f32_32x32x16_bf16(k0, qf[d0], p0, 0, 0, 0);
                    p1 = __builtin_amdgcn_mfma_f32_32x32x16_bf16(k1, qf[d0], p1, 0, 0, 0);
                }
                if (a.mode == 1) { const int dq = tl * 64 - (qw + r32);
#pragma unroll
                    for (int r = 0; r < 16; ++r) { const int d = dq + crow(r, hi); if (d > 128 || d < -128) p0[r] = NEGF; if (d + 32 > 128 || d + 32 < -128) p1[r] = NEGF; } }
                else { const int qc = 32 * (wid & 1) + r32, cs = clampi(qc - 8, 0, 48); const ATT_LAS float* trow = tbl + (tl - qr + 7) * 31 + 15 - qc;
#pragma unroll
                    for (int r = 0; r < 16; ++r) { const int kcl = crow(r, hi);
                        const float b0 = trow[kcl], b1 = trow[kcl + 32];
                        p0[r] = ((unsigned)(kcl - cs) < 16u) ? p0[r] + b0 : NEGF;
                        p1[r] = ((unsigned)(kcl + 32 - cs) < 16u) ? p1[r] + b1 : NEGF; } }
                const float mt = rowmax32(p0, p1);
                if (__any(mt > m)) { const float mn = fmaxf(m, mt), alpha = __builtin_amdgcn_exp2f(m - mn); m = mn; lsum *= alpha;
#pragma unroll
                    for (int r = 0; r < 16; ++r) { o0[r] *= alpha; o1[r] *= alpha; } }
                float sum = 0.f;
#pragma unroll
                for (int r = 0; r < 16; ++r) { p0[r] = __builtin_amdgcn_exp2f(p0[r] - m); p1[r] = __builtin_amdgcn_exp2f(p1[r] - m); sum += p0[r] + p1[r]; }
                lsum += sum;
                u32x4 pw[4];
#pragma unroll
                for (int j = 0; j < 4; ++j) { pw[0][j] = pk_bf16(p0[2 * j], p0[2 * j + 1]); pw[1][j] = pk_bf16(p0[8 + 2 * j], p0[8 + 2 * j + 1]);
                                              pw[2][j] = pk_bf16(p1[2 * j], p1[2 * j + 1]); pw[3][j] = pk_bf16(p1[8 + 2 * j], p1[8 + 2 * j + 1]); }
                const ATT_LAS unsigned char* vb = Vb + vlane;
#pragma unroll
                for (int s = 0; s < 4; ++s) {
                    const bf16x8 pa = __builtin_bit_cast(bf16x8, pw[s]);
                    { const s16x4 lo = vtr(vb + s * 1024), h4 = vtr(vb + s * 1024 + 512);
                      const bf16x8 vf = (bf16x8){lo[0], lo[1], lo[2], lo[3], h4[0], h4[1], h4[2], h4[3]};
                      o0 = __builtin_amdgcn_mfma_f32_32x32x16_bf16(vf, pa, o0, 0, 0, 0); }
                    { const s16x4 lo = vtr(vb + 4096 + s * 1024), h4 = vtr(vb + 4096 + s * 1024 + 512);
                      const bf16x8 vf = (bf16x8){lo[0], lo[1], lo[2], lo[3], h4[0], h4[1], h4[2], h4[3]};
                      o1 = __builtin_amdgcn_mfma_f32_32x32x16_bf16(vf, pa, o1, 0, 0, 0); }
                }
            }
            if (t + 1 < nlat) { *(ATT_LAS u32x4*)(ATT_KBUF(cur ^ 1) + koff) = kreg; *(ATT_LAS u32x4*)(ATT_VBUF(cur ^ 1) + voff) = vreg; }
            __syncthreads();
        }
    }
#undef ATT_TROW
#undef ATT_KBUF
#undef ATT_VBUF
#undef ATT_LDK
    lsum = halfsum(lsum);
    lsum += __builtin_amdgcn_exp2f(a.sink - m);
    const float inv = 1.0f / lsum;
    bf16_t* yr = Y + ((size_t)(qrow >> 8) * 16 + (a.qcol >> 6)) * 16384 + (qrow & 255) * 64 + 4 * hi;
#pragma unroll
    for (int g = 0; g < 4; ++g) {
        u32x2 w0, w1;
        w0.x = pk_bf16(o0[4 * g] * inv, o0[4 * g + 1] * inv); w0.y = pk_bf16(o0[4 * g + 2] * inv, o0[4 * g + 3] * inv);
        w1.x = pk_bf16(o1[4 * g] * inv, o1[4 * g + 1] * inv); w1.y = pk_bf16(o1[4 * g + 2] * inv, o1[4 * g + 3] * inv);
        *(u32x2*)(yr + 8 * g) = w0; *(u32x2*)(yr + 32 + 8 * g) = w1;
    }
}
}
#define LAS __attribute__((address_space(3)))
typedef unsigned short bf16;
typedef float f32x4 __attribute__((ext_vector_type(4)));
typedef unsigned v4u __attribute__((ext_vector_type(4)));
typedef unsigned v2u __attribute__((ext_vector_type(2)));
#ifndef NORM_REP
#define NORM_REP 1
#endif
#ifndef PRO_REP
#define PRO_REP 1
#endif
#ifndef SYNC_REP
#define SYNC_REP 1
#endif
#define GSYNC() do { unsigned oq_; asm volatile("s_mov_b32 %0, 0" : "=s"(oq_)); XcdBarrier xb_; xb_.bar = (unsigned*)(GASQ unsigned*)ldp_raw(lds0 + oq_, 23); xb_.x = xb_xcc_id(); xb_.st = (volatile LAS unsigned*)(lds0 + oq_ + MISC_OFF); for (int r_ = 0; r_ < SYNC_REP; ++r_) xcd_barrier(xb_); } while (0)
#ifndef G2_PMMASK
#define G2_PMMASK 0x7fffffff
#endif
#ifndef G2_REP
#define G2_REP 1
#endif
#ifndef G3_REP
#define G3_REP 1
#endif
#ifndef G1_REP
#define G1_REP 1
#endif
#ifndef ATT_EXTRA
#define ATT_EXTRA 0
#endif
#ifndef ATT_REP_N
#define ATT_REP_N 512
#endif
#ifndef PM
#define PM 127
#endif
constexpr int NWAVES = 8, NTHREADS = 512;
constexpr int D = 1024, FF = 2816, NLAT = 32768, NCTX = 1024, MFULL = NLAT + NCTX, WIN = 2304, MODROW = 9216, DEPTH = 2;
constexpr float EPS = 1e-6f;
constexpr size_t MiB = 1u << 20;
constexpr size_t WS_MOD = 1 * MiB, WS_COS = 2 * MiB, WS_SIN = 3 * MiB, WS_HC = 4 * MiB, WS_W = 8 * MiB;
constexpr size_t WL_GU1 = 0, WL_D1 = 11 * MiB, WL_IN = 16 * MiB + MiB / 2, WL_OUT = 21 * MiB, WL_GU2 = 23 * MiB, WL_D2 = 34 * MiB, WL_SIZE = 39 * MiB + MiB / 2;
constexpr size_t WS_U = 88 * MiB, WS_HID = 154 * MiB, WS_PART = 336 * MiB, WS_DUMMY = 352 * MiB, WS_END = 352 * MiB;
static_assert(WS_W + 2 * WL_SIZE <= WS_U && WS_U + (size_t)MFULL * D * 2 <= WS_HID && WS_HID + (size_t)MFULL * FF * 2 <= WS_PART, "ws map");
constexpr int LDS_BYTES = 147456;

__device__ __forceinline__ unsigned f2bf(float f) { unsigned u = __builtin_bit_cast(unsigned, f); return (u + 0x7fffu + ((u >> 16) & 1u)) >> 16; }
__device__ __forceinline__ unsigned pk2(float lo, float hi) { return f2bf(lo) | (f2bf(hi) << 16); }
__device__ __forceinline__ float wave_sum(float v) {
#pragma unroll
    for (int o = 1; o < 64; o <<= 1) v += __shfl_xor(v, o);
    return v;
}
__device__ __forceinline__ void transpose_item(const float* W, int K, int N, bf16* WT, int dst_row0, int k0, int n0, LAS float* scr, int lane) {
    f32x4 wv[8];
#pragma unroll
    for (int i = 0; i < 8; ++i) wv[i] = *(const f32x4*)(W + (size_t)(k0 + 8 * i + (lane >> 3)) * N + n0 + 4 * (lane & 7));
#pragma unroll
    for (int i = 0; i < 8; ++i) { LAS float* d = scr + (8 * i + (lane >> 3)) * 33 + 4 * (lane & 7); d[0] = wv[i][0]; d[1] = wv[i][1]; d[2] = wv[i][2]; d[3] = wv[i][3]; }
    asm volatile("s_waitcnt lgkmcnt(0)" ::: "memory");
    const int c = lane & 7;
#pragma unroll
    for (int j = 0; j < 4; ++j) { const int n = (lane >> 3) + 8 * j; const LAS float* s = scr + (8 * c) * 33 + n;
        v4u o; o.x = pk2(s[0 * 33], s[1 * 33]); o.y = pk2(s[2 * 33], s[3 * 33]); o.z = pk2(s[4 * 33], s[5 * 33]); o.w = pk2(s[6 * 33], s[7 * 33]);
        const int rr = dst_row0 + n; *(v4u*)(WT + ((size_t)(rr >> 8) * (K >> 6) + (k0 >> 6)) * 16384 + (rr & 255) * 64 + 8 * c) = o; }
    asm volatile("s_waitcnt lgkmcnt(0)" ::: "memory");
}

#define XB_TMO      128
#define XB_XCNT(j)  (256  + 64 * (j))
#define XB_XSUB(j)  (1280 + 64 * (j))
#define XB_XGEN(j)  (2304 + 64 * (j))
#define XB_TOP      3328
#define XB_TOPGEN   3392
#define XCD_BAR_WORDS 3456
#define XB_SPIN_CAP (1u << 18)

__device__ __forceinline__ unsigned xb_ld(unsigned* p)              { return __hip_atomic_load(p, __ATOMIC_RELAXED, __HIP_MEMORY_SCOPE_AGENT); }
__device__ __forceinline__ unsigned xb_add(unsigned* p, unsigned v) { return __hip_atomic_fetch_add(p, v, __ATOMIC_RELAXED, __HIP_MEMORY_SCOPE_AGENT); }
__device__ __forceinline__ unsigned xb_xcc_id() { return (unsigned)__builtin_amdgcn_s_getreg((3 << 11) | 20) & 0xFu; }
#define XB_SPIN(cond, bar) do { unsigned _sp = 0; while (cond) { __builtin_amdgcn_s_sleep(1); \
    if ((++_sp & 255u) == 0u) { if (xb_ld(&(bar)[XB_TMO])) break; if (_sp > XB_SPIN_CAP) { atomicAdd(&(bar)[XB_TMO], 1u); break; } } } } while (0)

struct XcdBarrier {
    unsigned* bar; unsigned x;
    volatile LAS unsigned* st;
};

__device__ __forceinline__ XcdBarrier xcd_barrier_post(unsigned* bar, volatile LAS unsigned* st) {
    XcdBarrier b; b.bar = bar; b.x = xb_xcc_id(); b.st = st;
    if (threadIdx.x == 0) (void)xb_add(&bar[XB_XCNT(b.x)], 1u);
    return b;
}
__device__ __forceinline__ void xcd_barrier_complete(unsigned* bar, unsigned x, unsigned& nloc, unsigned& nx) {
    const unsigned G = gridDim.x * gridDim.y * gridDim.z;
    unsigned sum, cnt, mine, sp = 0u;
    for (;;) {
        sum = 0u; cnt = 0u; mine = 0u;
#pragma unroll
        for (unsigned j = 0; j < 16; ++j) { const unsigned c = xb_ld(&bar[XB_XCNT(j)]); sum += c; cnt += (c > 0u) ? 1u : 0u; mine = (j == x) ? c : mine; }
        if (sum == G) break;
        __builtin_amdgcn_s_sleep(1);
        if ((++sp & 255u) == 0u) { if (xb_ld(&bar[XB_TMO])) break; if (sp > XB_SPIN_CAP) { atomicAdd(&bar[XB_TMO], 1u); break; } }
    }
    nloc = mine > 0u ? mine : 1u; nx = cnt > 0u ? cnt : 1u;
}

__device__ __forceinline__ void xcd_barrier(const XcdBarrier& b) {
    asm volatile("s_waitcnt vmcnt(0)" ::: "memory");
    __syncthreads();
    if (threadIdx.x == 0) {
        unsigned* bar = b.bar;
        __builtin_amdgcn_s_waitcnt(0);
        unsigned nloc = b.st[0], nx = b.st[1];
        if (nloc == 0u) { xcd_barrier_complete(bar, b.x, nloc, nx); b.st[0] = nloc; b.st[1] = nx; }
        const unsigned old = xb_add(&bar[XB_XSUB(b.x)], 1u);
        const unsigned gen = old / nloc;
        if (old + 1u == (gen + 1u) * nloc) {
            __builtin_amdgcn_fence(__ATOMIC_RELEASE, "agent");
            asm volatile("s_waitcnt vmcnt(0)" ::: "memory");
            const unsigned og = xb_add(&bar[XB_TOP], 1u);
            const unsigned tg = og / nx;
            if (og + 1u == (tg + 1u) * nx) xb_add(&bar[XB_TOPGEN], 1u);
            else XB_SPIN(xb_ld(&bar[XB_TOPGEN]) == tg, bar);
            __builtin_amdgcn_fence(__ATOMIC_ACQUIRE, "agent");
            xb_add(&bar[XB_XGEN(b.x)], 1u);
            asm volatile("s_waitcnt vmcnt(0)" ::: "memory");
        } else {
            XB_SPIN(xb_ld(&bar[XB_XGEN(b.x)]) == gen, bar);
            __builtin_amdgcn_fence(__ATOMIC_ACQUIRE, "agent");
            asm volatile("s_waitcnt vmcnt(0)" ::: "memory");
        }
    }
    __syncthreads();
}

struct Args { const float* in[22]; float* out; unsigned char* ws; };
constexpr int PTAB_OFF = 131072, MISC_OFF = 131072 + 256;
__device__ __forceinline__ unsigned long long ldp_raw(LAS unsigned char* lds, int i) { const unsigned long long v = ((volatile LAS unsigned long long*)(lds + PTAB_OFF))[i];
    const unsigned lo = __builtin_amdgcn_readfirstlane((unsigned)v), hi = __builtin_amdgcn_readfirstlane((unsigned)(v >> 32)); return ((unsigned long long)hi << 32) | lo; }
#define GASQ __attribute__((address_space(1)))
#define INP(i) ((const float*)(const GASQ float*)ldp_raw(lds, (i)))
#define OUTP ((float*)(GASQ float*)ldp_raw(lds, 22))
#define WSP ((unsigned char*)(GASQ unsigned char*)ldp_raw(lds, 23))

__device__ __forceinline__ void mod_task(const Args& A, int task, LAS float* ldsf, int tid) {
    const int l = task / 72, cb = task % 72;
    LAS float* sc = ldsf; LAS float* red = ldsf + 5120;
    for (int i = tid; i < 5120; i += NTHREADS) { const int r = i >> 10, k = i & 1023; const float x = r < 4 ? A.in[1][r * 1024 + k] : A.in[3][k]; sc[i] = x / (1.0f + __expf(-x)); }
    __syncthreads();
    const int quad = tid & 31, ks = tid >> 5;
    const float* W = A.in[4] + (size_t)l * D * MODROW + cb * 128 + quad * 4;
    f32x4 acc[5];
#pragma unroll
    for (int r = 0; r < 5; ++r) acc[r] = (f32x4){0.f, 0.f, 0.f, 0.f};
#pragma unroll 16
    for (int kk = 0; kk < 64; ++kk) { const int k = ks * 64 + kk; const f32x4 w = *(const f32x4*)(W + (size_t)k * MODROW);
#pragma unroll
        for (int r = 0; r < 5; ++r) acc[r] += w * sc[r * 1024 + k]; }
#pragma unroll
    for (int r = 0; r < 5; ++r) *(LAS f32x4*)(red + (ks * 5 + r) * 128 + quad * 4) = acc[r];
    __syncthreads();
    float* mod = (float*)(A.ws + WS_MOD);
    for (int i = tid; i < 640; i += NTHREADS) { const int r = i >> 7, col = i & 127; float s = 0.f;
#pragma unroll
        for (int k2 = 0; k2 < 16; ++k2) s += red[(k2 * 5 + r) * 128 + col];
        mod[(size_t)(l * 5 + r) * MODROW + cb * 128 + col] = s + A.in[5][l * MODROW + cb * 128 + col]; }
    __syncthreads();
}

__device__ __forceinline__ void norm_phase(const float* h_lat, const float* h_ctx, int M, const float* gain, const float* modl, int shift_idx, bf16* U, int gw, int ngw, int lane,
                                           const float* part, const float* pgate, float* hc_out) {
    for (int grp = gw; grp < M / 4; grp += ngw) {
        const int row = grp * 4;
        const float* xr = row < NLAT ? h_lat + (size_t)row * D : h_ctx + (size_t)(row - NLAT) * D;
        const int r5 = row < NLAT ? (row >> 13) : 4;
        const f32x4* sh = (const f32x4*)(modl + (size_t)r5 * MODROW + shift_idx * D) + lane; const f32x4* sc = sh + D / 4;
        const f32x4* x4 = (const f32x4*)xr + lane; const f32x4* g4 = (const f32x4*)gain + lane;
        f32x4 v[4][4]; float ss[4];
#pragma unroll
        for (int q = 0; q < 4; ++q)
#pragma unroll
            for (int j = 0; j < 4; ++j) v[q][j] = x4[q * (D / 4) + 64 * j];
        f32x4 gm[4], sf[4];
#pragma unroll
        for (int j = 0; j < 4; ++j) { gm[j] = g4[64 * j] * (sc[64 * j] + 1.0f); sf[j] = sh[64 * j]; }
        if (part != nullptr && row >= NLAT) {
            const f32x4* pg4 = (const f32x4*)pgate + lane;
#pragma unroll
            for (int q = 0; q < 4; ++q) { const f32x4* p4 = (const f32x4*)(part + (size_t)(row - NLAT + q) * D) + lane; f32x4* ho = (f32x4*)(hc_out + (size_t)(row - NLAT + q) * D) + lane;
#pragma unroll
                for (int j = 0; j < 4; ++j) { const f32x4 ps = (p4[64 * j] + p4[64 * j + 262144]) + (p4[64 * j + 2 * 262144] + p4[64 * j + 3 * 262144]);
                    v[q][j] += pg4[64 * j] * 0.5f * ps; ho[64 * j] = v[q][j]; } }
        }
#pragma unroll
        for (int q = 0; q < 4; ++q) { float a = 0.f;
#pragma unroll
            for (int j = 0; j < 4; ++j) a += (v[q][j][0] * v[q][j][0] + v[q][j][1] * v[q][j][1]) + (v[q][j][2] * v[q][j][2] + v[q][j][3] * v[q][j][3]);
            ss[q] = a; }
#pragma unroll
        for (int o = 1; o < 64; o <<= 1) {
#pragma unroll
            for (int q = 0; q < 4; ++q) ss[q] += __shfl_xor(ss[q], o); }
#pragma unroll
        for (int q = 0; q < 4; ++q) { const float rstd = 1.0f / sqrtf(ss[q] * (1.0f / D) + EPS);
            const int rr = row + q; bf16* ob = U + (size_t)(rr >> 8) * 16 * 16384 + (rr & 255) * 64 + (size_t)(lane >> 4) * 16384 + 4 * (lane & 15);
#pragma unroll
            for (int j = 0; j < 4; ++j) { const f32x4 y = v[q][j] * rstd * gm[j] + sf[j]; v2u w; w.x = pk2(y[0], y[1]); w.y = pk2(y[2], y[3]); *(v2u*)(ob + (size_t)j * 4 * 16384) = w; } }
    }
}

__global__ void __launch_bounds__(NTHREADS, 2) fwd_megakernel(Args A) {
    extern __shared__ __attribute__((aligned(16))) unsigned char lds_raw[];
    cg::grid_group grid = cg::this_grid();
    LAS unsigned char* lds0 = (LAS unsigned char*)lds_raw;
    const int wave = __builtin_amdgcn_readfirstlane(threadIdx.x >> 6);
    if (threadIdx.x == 0) { LAS unsigned long long* pt = (LAS unsigned long long*)(lds0 + PTAB_OFF);
#pragma unroll
        for (int i = 0; i < 22; ++i) pt[i] = (unsigned long long)A.in[i];
        pt[22] = (unsigned long long)A.out; pt[23] = (unsigned long long)A.ws;
        ((LAS unsigned*)(lds0 + MISC_OFF))[0] = 0u; ((LAS unsigned*)(lds0 + MISC_OFF))[1] = 0u; }
    __syncthreads();
    (void)xcd_barrier_post((unsigned*)A.ws, (volatile LAS unsigned*)(lds0 + MISC_OFF));

    for (int prep = 0; prep < PRO_REP; ++prep) {
        LAS unsigned char* lds = lds0; const int tid = threadIdx.x, lane = tid & 63;
        const int G = gridDim.x, bx = blockIdx.x, gw = bx * NWAVES + wave, ngw = G * NWAVES;
        unsigned char* ws = A.ws;
        float* cosT = (float*)(ws + WS_COS); float* sinT = (float*)(ws + WS_SIN);
        if (bx < 144) mod_task(A, bx, (LAS float*)lds, tid);
        for (int i = bx * NTHREADS + tid; i < 8192 * 32; i += G * NTHREADS) { const int t = i >> 5, j = i & 31; const float pos = (float)(j < 16 ? (t >> 6) : (t & 63));
            const float inv = exp2f(-(float)(j & 15) * (13.287712379549449f / 16.0f)); float rev = pos * inv * 0.15915494309189535f; rev -= floorf(rev);
            cosT[i] = __builtin_amdgcn_cosf(rev); sinT[i] = __builtin_amdgcn_sinf(rev); }
        LAS float* scr = (LAS float*)(lds + wave * 16384);
        constexpr int I_G = (D / 64) * (FF / 32), I_D = (FF / 64) * (D / 32), I_IN = (D / 64) * (WIN / 32), I_O = (D / 64) * (D / 32);
        constexpr int PER_L = 2 * (2 * I_G + I_D) + I_IN + I_O;
        for (int it = gw; it < DEPTH * PER_L; it += ngw) {
            const int l = it / PER_L; int r = it % PER_L; unsigned char* wl = ws + WS_W + (size_t)l * WL_SIZE;
            if (r < 2 * (2 * I_G + I_D)) {
                const int f = r / (2 * I_G + I_D); r -= f * (2 * I_G + I_D);
                bf16* gu = (bf16*)(wl + (f ? WL_GU2 : WL_GU1)); bf16* dn = (bf16*)(wl + (f ? WL_D2 : WL_D1));
                if (r < 2 * I_G) { const int up = r / I_G; r -= up * I_G; const int nb = FF / 32, kb = r / nb, n0 = (r % nb) * 32;
                    const float* W = (f ? (up ? A.in[19] : A.in[18]) : (up ? A.in[8] : A.in[7])) + (size_t)l * D * FF;
                    transpose_item(W, D, FF, gu, 256 * (n0 >> 7) + (n0 & 127) + 128 * up, kb * 64, n0, scr, lane); }
                else { r -= 2 * I_G; const int nb = D / 32, kb = r / nb, n0 = (r % nb) * 32;
                    const float* W = (f ? A.in[20] : A.in[9]) + (size_t)l * FF * D;
                    transpose_item(W, FF, D, dn, n0, kb * 64, n0, scr, lane); }
            } else { r -= 2 * (2 * I_G + I_D);
                if (r < I_IN) { const int nb = WIN / 32, kb = r / nb, n0 = (r % nb) * 32; const int nl = n0 & 255;
                    const float* W = A.in[11] + (size_t)l * D * WIN;
                    transpose_item(W, D, WIN, (bf16*)(wl + WL_IN), (n0 & ~255) + 128 * ((nl & 63) >> 5) + 32 * (nl >> 6), kb * 64, n0, scr, lane); }
                else { r -= I_IN; const int nb = D / 32, kb = r / nb, n0 = (r % nb) * 32;
                    const float* W = A.in[16] + (size_t)l * D * D;
                    transpose_item(W, D, D, (bf16*)(wl + WL_OUT), n0, kb * 64, n0, scr, lane); }
            }
        }
        if (PRO_REP > 1) __syncthreads();
    }
    if (gridDim.x == 0x7fffffffu) grid.sync();
    GSYNC();

#define GW_DECL unsigned opq_; asm volatile("s_mov_b32 %0, 0" : "=s"(opq_)); LAS unsigned char* lds = lds0 + opq_; int lane = (int)(threadIdx.x & 63); asm volatile("" : "+v"(lane)); int G = gridDim.x, bx = blockIdx.x; asm volatile("" : "+s"(G), "+s"(bx)); int wave = __builtin_amdgcn_readfirstlane(threadIdx.x >> 6); asm volatile("" : "+s"(wave)); unsigned char* ws = WSP
#define NORM_ARGS const int gw = bx * NWAVES + wave, ngw = G * NWAVES
#pragma unroll 1
    for (int l = 0; l < DEPTH; ++l) {
        { GW_DECL; NORM_ARGS; const float* src_lat = l == 0 ? INP(0) : (const float*)OUTP; const float* src_ctx = l == 0 ? INP(2) : (const float*)(ws + WS_HC);
          for (int nrep = 0; nrep < NORM_REP; ++nrep) norm_phase(src_lat, src_ctx, MFULL, INP(6) + l * D, (const float*)(ws + WS_MOD) + (size_t)l * 5 * MODROW, 0, (bf16*)(ws + WS_U), gw, ngw, lane,
                     l == 0 ? (const float*)nullptr : (const float*)(ws + WS_PART), (const float*)(ws + WS_MOD) + 4 * MODROW + 8 * D, (float*)(ws + WS_HC)); }
        GSYNC();
#if PM & 1
        { GW_DECL; pg8::Gemm g{(const bf16*)(ws + WS_U), (const bf16*)(ws + WS_W + (size_t)l * WL_SIZE + WL_GU1), MFULL, 2 * FF, D}; pg8::StaticOrder S; S.init(MFULL, 2 * FF, G, bx, D);
          pg8::EpiSwiGLU E{(bf16*)(ws + WS_HID), FF}; pg8::gemm_phase<pg8::EpiSwiGLU, pg8::StaticOrder, true, true>(lds, g, S, E); }
#endif
        GSYNC();
#if PM & 2
        for (int rep = 0; rep < ((l == 0) ? G2_REP : 1); ++rep)
        { GW_DECL; float* hl = OUTP; float* hc = (float*)(ws + WS_HC); const float* src_lat = l == 0 ? INP(0) : (const float*)hl; const float* src_ctx = l == 0 ? INP(2) : (const float*)hc;
          pg8::Gemm g{(const bf16*)(ws + WS_HID), (const bf16*)(ws + WS_W + (size_t)l * WL_SIZE + WL_D1), MFULL, D, FF}; pg8::CtxSplitOrder S; S.init(G, bx, FF, 64, NLAT, 0, rep ? G2_PMMASK : 0x7fffffff);
          pg8::EpiRes E{src_lat, src_ctx, rep ? (float*)(ws + WS_DUMMY) : hl, hc, (const float*)(ws + WS_MOD) + (size_t)l * 5 * MODROW + 2 * D, 0.5f, (float*)(ws + WS_PART)}; pg8::gemm_phase<pg8::EpiRes, pg8::CtxSplitOrder, true, true>(lds, g, S, E); }
#endif
        GSYNC();
        { GW_DECL; NORM_ARGS;
          for (int nrep = 0; nrep < NORM_REP; ++nrep) norm_phase(OUTP, l == 0 ? INP(2) : (const float*)(ws + WS_HC), MFULL, INP(10) + l * D, (const float*)(ws + WS_MOD) + (size_t)l * 5 * MODROW, 3, (bf16*)(ws + WS_U), gw, ngw, lane,
                     (const float*)(ws + WS_PART), (const float*)(ws + WS_MOD) + (size_t)l * 5 * MODROW + 4 * MODROW + 2 * D, (float*)(ws + WS_HC)); }
        GSYNC();
#if PM & 4
        for (int rep = 0; rep < ((l == 0) ? G3_REP : 1); ++rep)
        { GW_DECL; pg8::Gemm g{(const bf16*)(ws + WS_U), (const bf16*)(ws + WS_W + (size_t)l * WL_SIZE + WL_IN), MFULL, WIN, D}; pg8::StaticOrder S; S.init(MFULL, WIN, G, bx, D);
          pg8::EpiQKV E{(bf16*)(ws + WS_HID), WIN, INP(12) + l * 64, INP(13) + l * 64, (const float*)(ws + WS_COS), (const float*)(ws + WS_SIN)};
          pg8::gemm_phase<pg8::EpiQKV, pg8::StaticOrder, true, true>(lds, g, S, E); }
#endif
        GSYNC();
#if PM & 8
        { GW_DECL; const int nunits = (l == DEPTH - 1) ? 2048 : 2112; const float* sink_l = INP(14) + l * 6; const float* rpb_l = INP(15) + (size_t)l * 6 * 465; const float* qn_l = INP(12) + l * 64; const float* kn_l = INP(13) + l * 64;
          const bf16* P = (const bf16*)(ws + WS_HID); bf16* Y = (bf16*)(ws + WS_U);
#pragma unroll 1
          for (int v = bx; v < nunits + ATT_EXTRA; v += G) att::attn_unit(v < nunits ? v : v - nunits, sink_l, P, Y, lds, rpb_l, qn_l, kn_l); }
#endif
        GSYNC();
#if PM & 16
        { GW_DECL; const int M2 = (l == DEPTH - 1) ? NLAT : MFULL; float* hl = OUTP; float* hc = (float*)(ws + WS_HC);
          pg8::Gemm g{(const bf16*)(ws + WS_U), (const bf16*)(ws + WS_W + (size_t)l * WL_SIZE + WL_OUT), M2, D, D}; pg8::StaticOrder S; S.init(M2, D, G, bx, D);
          pg8::EpiRes E{hl, hc, hl, hc, (const float*)(ws + WS_MOD) + (size_t)l * 5 * MODROW + 5 * D, 1.0f, nullptr}; pg8::gemm_phase<pg8::EpiRes, pg8::StaticOrder, true, true>(lds, g, S, E); }
#endif
        GSYNC();
        { GW_DECL; NORM_ARGS; const int M2 = (l == DEPTH - 1) ? NLAT : MFULL;
          for (int nrep = 0; nrep < NORM_REP; ++nrep) norm_phase(OUTP, (const float*)(ws + WS_HC), M2, INP(17) + l * D, (const float*)(ws + WS_MOD) + (size_t)l * 5 * MODROW, 6, (bf16*)(ws + WS_U), gw, ngw, lane, (const float*)nullptr, (const float*)nullptr, (float*)nullptr); }
        GSYNC();
#if PM & 32
        { GW_DECL; const int M2 = (l == DEPTH - 1) ? NLAT : MFULL;
          pg8::Gemm g{(const bf16*)(ws + WS_U), (const bf16*)(ws + WS_W + (size_t)l * WL_SIZE + WL_GU2), M2, 2 * FF, D}; pg8::StaticOrder S; S.init(M2, 2 * FF, G, bx, D);
          pg8::EpiSwiGLU E{(bf16*)(ws + WS_HID), FF}; pg8::gemm_phase<pg8::EpiSwiGLU, pg8::StaticOrder, true, true>(lds, g, S, E); }
#endif
        GSYNC();
#if PM & 64
        { GW_DECL; const int M2 = (l == DEPTH - 1) ? NLAT : MFULL; float* hl = OUTP; float* hc = (float*)(ws + WS_HC);
          pg8::Gemm g{(const bf16*)(ws + WS_HID), (const bf16*)(ws + WS_W + (size_t)l * WL_SIZE + WL_D2), M2, D, FF}; pg8::CtxSplitOrder S; S.init(G, bx, FF, M2 == MFULL ? 64 : 0, NLAT, 0, 0x7fffffff);
          pg8::EpiRes E{hl, hc, hl, hc, (const float*)(ws + WS_MOD) + (size_t)l * 5 * MODROW + 8 * D, 0.5f, (float*)(ws + WS_PART)}; pg8::gemm_phase<pg8::EpiRes, pg8::CtxSplitOrder, true, true>(lds, g, S, E); }
#endif
        GSYNC();
    }
    { GW_DECL; NORM_ARGS; float* hl = OUTP; const float* gf = INP(21); (void)ws;
      for (int grp = gw; grp < NLAT / 4; grp += ngw) {
        f32x4* x4 = (f32x4*)(hl + (size_t)grp * 4 * D) + lane; const f32x4* g4 = (const f32x4*)gf + lane;
        f32x4 v[4][4]; float ss[4];
#pragma unroll
        for (int q = 0; q < 4; ++q)
#pragma unroll
            for (int j = 0; j < 4; ++j) v[q][j] = x4[q * (D / 4) + 64 * j];
#pragma unroll
        for (int q = 0; q < 4; ++q) { float a = 0.f;
#pragma unroll
            for (int j = 0; j < 4; ++j) a += (v[q][j][0] * v[q][j][0] + v[q][j][1] * v[q][j][1]) + (v[q][j][2] * v[q][j][2] + v[q][j][3] * v[q][j][3]);
            ss[q] = a; }
#pragma unroll
        for (int o = 1; o < 64; o <<= 1) {
#pragma unroll
            for (int q = 0; q < 4; ++q) ss[q] += __shfl_xor(ss[q], o); }
#pragma unroll
        for (int q = 0; q < 4; ++q) { const float rstd = 1.0f / sqrtf(ss[q] * (1.0f / D) + EPS);
#pragma unroll
            for (int j = 0; j < 4; ++j) x4[q * (D / 4) + 64 * j] = v[q][j] * rstd * g4[64 * j]; }
      } }
}

extern "C" void kernel_launch(void* const* d_in, const int* in_sizes, int n_in, void* d_out, int out_size, void* d_ws, size_t ws_size, hipStream_t stream) {
    static int grid_blocks = 0;
    if (grid_blocks == 0) {
        if (n_in != 22 || out_size != NLAT * D || ws_size < WS_END) { fprintf(stderr, "kernel_launch: unexpected shapes (n_in %d out %d ws %zu)\n", n_in, out_size, ws_size); grid_blocks = -1; return; }
        int dev = 0, cus = 0, per_cu = 0;
        hipGetDevice(&dev); hipDeviceGetAttribute(&cus, hipDeviceAttributeMultiprocessorCount, dev);
        if (hipFuncSetAttribute((const void*)fwd_megakernel, hipFuncAttributeMaxDynamicSharedMemorySize, LDS_BYTES) != hipSuccess) { fprintf(stderr, "hipFuncSetAttribute failed\n"); grid_blocks = -1; return; }
        if (hipOccupancyMaxActiveBlocksPerMultiprocessor(&per_cu, (const void*)fwd_megakernel, NTHREADS, LDS_BYTES) != hipSuccess || per_cu < 1) per_cu = 1;
        (void)hipGetLastError();
        grid_blocks = cus * per_cu;
        fprintf(stderr, "kernel_launch: %d CUs x %d = grid %d\n", cus, per_cu, grid_blocks);
    }
    if (grid_blocks < 0) return;
    if (hipMemsetAsync(d_ws, 0, 65536, stream) != hipSuccess) { fprintf(stderr, "memset failed\n"); return; }
    Args a{};
    for (int i = 0; i < 22; ++i) a.in[i] = (const float*)d_in[i];
    a.out = (float*)d_out; a.ws = (unsigned char*)d_ws;
    void* args[] = {&a};
    hipError_t e = hipLaunchCooperativeKernel((const void*)fwd_megakernel, dim3(grid_blocks), dim3(NTHREADS), args, LDS_BYTES, stream);
    if (e != hipSuccess) fprintf(stderr, "cooperative launch failed: %s (grid %d)\n", hipGetErrorString(e), grid_blocks);
}
```
